# Optimizing an MI355X kernel written in HIP

```python
import math
import numpy as np
import jax
import jax.numpy as jnp
from jax import lax

D_MODEL = 1024
BATCH = 8
SEQ = 4096
DEPTH = 2

BRANCH_W = 512
HEAD_DIM = 64
NSA_HEADS = 8
NSA_KV_GROUPS = 2
NSA_HPG = NSA_HEADS // NSA_KV_GROUPS
CMP_BLOCK = 32
CMP_STRIDE = 16
CMP_HIDDEN = 256
SLC_BLOCK = 64
SLC_TOP = 16
WINDOW = 512
Q_BLOCK = 128
S5_GROUPS = 32
S5_GROUP_CH = 16
S5_STATE = 64
RWKV_HEADS = 8
DECAY_LORA = 64
AAA_LORA = 64
N_BRANCH = 3
ROPE_THETA = 10000.0
NORM_EPS = 1e-6
RWKV_LN_EPS = 64e-5
NEG_BIG = -1e30
KV_W = NSA_KV_GROUPS * HEAD_DIM
RWKV_MIX_W = 3 * BRANCH_W + DECAY_LORA + AAA_LORA
IN_SPLITS = (BRANCH_W, 6 * KV_W, 3 * NSA_HEADS, BRANCH_W,
             BRANCH_W, BRANCH_W,
             RWKV_MIX_W, BRANCH_W,
             N_BRANCH * D_MODEL)
IN_W = 5 * BRANCH_W + 6 * KV_W + 3 * NSA_HEADS + RWKV_MIX_W + N_BRANCH * D_MODEL

kernel_name = "hybrid_nsa_s5_rwkv7_adaln"


def _split(t, sizes):
    idx = np.cumsum(np.array(sizes))[:-1].tolist()
    return jnp.split(t, idx, axis=-1)


def _rmsnorm(x, w):
    xf = x.astype(jnp.float32)
    y = xf * lax.rsqrt(jnp.mean(xf * xf, axis=-1, keepdims=True) + NORM_EPS)
    return (y * w.astype(jnp.float32)).astype(x.dtype)


def _rope_tables(seq):
    half = HEAD_DIM // 2
    inv = jnp.exp(-math.log(ROPE_THETA) * jnp.arange(half, dtype=jnp.float32) / half)
    ang = jnp.arange(seq, dtype=jnp.float32)[:, None] * inv[None, :]
    return jnp.cos(ang), jnp.sin(ang)


def _rope(t, cos, sin):
    t1, t2 = jnp.split(t.astype(jnp.float32), 2, axis=-1)
    cc = cos[None, :, None, :]
    ss = sin[None, :, None, :]
    return jnp.concatenate([t1 * cc - t2 * ss, t1 * ss + t2 * cc], axis=-1).astype(t.dtype)


def _compress(t, pos, w1, w2):
    bn, s, g, dh = t.shape
    n_cmp = (s - CMP_BLOCK) // CMP_STRIDE + 1
    idx = CMP_STRIDE * np.arange(n_cmp)[:, None] + np.arange(CMP_BLOCK)[None, :]
    blk = t[:, idx] + pos[None, None, :, None, :]
    blk = jnp.moveaxis(blk, 3, 2).reshape(bn, n_cmp, g, CMP_BLOCK * dh)
    return jax.nn.silu(blk @ w1) @ w2


def _nsa(q, kc, vc, ks, vs, kw, vw, gates, pos_k, pos_v, w1k, w2k, w1v, w2v):
    bn, s = q.shape[:2]
    G, R, Dh = NSA_KV_GROUPS, NSA_HPG, HEAD_DIM
    scale = Dh ** -0.5
    k_cmp = _compress(kc, pos_k, w1k, w2k)
    v_cmp = _compress(vc, pos_v, w1v, w2v)
    n_cmp = k_cmp.shape[1]
    cmp_end = CMP_STRIDE * np.arange(n_cmp) + CMP_BLOCK - 1
    n_slc = s // SLC_BLOCK
    top = min(SLC_TOP, n_slc)
    cs = CMP_STRIDE * np.arange(n_cmp)[:, None]
    ss = SLC_BLOCK * np.arange(n_slc)[None, :]
    overlap = np.clip(np.minimum(cs + CMP_BLOCK, ss + SLC_BLOCK) - np.maximum(cs, ss), 0, None)
    cmp_to_slc = jnp.asarray(overlap / CMP_BLOCK, dtype=jnp.float32)
    ks_blk = jnp.moveaxis(ks.reshape(bn, n_slc, SLC_BLOCK, G, Dh), 3, 1)
    vs_blk = jnp.moveaxis(vs.reshape(bn, n_slc, SLC_BLOCK, G, Dh), 3, 1)
    kw_pad = jnp.pad(kw, ((0, 0), (WINDOW, 0), (0, 0), (0, 0)))
    vw_pad = jnp.pad(vw, ((0, 0), (WINDOW, 0), (0, 0), (0, 0)))
    n_qb = s // Q_BLOCK
    q_b = jnp.moveaxis(q.reshape(bn, n_qb, Q_BLOCK, G, R, Dh), 1, 0)
    g_b = jnp.moveaxis(gates.reshape(bn, n_qb, Q_BLOCK, G, R, 3), 1, 0)
    starts = jnp.arange(n_qb, dtype=jnp.int32) * Q_BLOCK
    b_ix = jnp.arange(bn)[:, None, None, None]
    g_ix = jnp.arange(G)[None, None, :, None]
    j_slc = jnp.arange(n_slc)

    def block(args):
        qb, gb, s0 = args
        t = s0 + jnp.arange(Q_BLOCK)
        s_c = jnp.einsum('bqgrd,bngd->bqgrn', qb, k_cmp).astype(jnp.float32) * scale
        valid_c = (cmp_end[None, :] <= t[:, None])[None, :, None, None, :]
        p_c = jax.nn.softmax(jnp.where(valid_c, s_c, NEG_BIG), axis=-1) * valid_c
        o_c = jnp.einsum('bqgrn,bngd->bqgrd', p_c.astype(v_cmp.dtype), v_cmp)
        imp = jnp.einsum('bqgrn,nm->bqgm', p_c, cmp_to_slc)
        blk_t = t // SLC_BLOCK
        causal_blk = (j_slc[None, :] <= blk_t[:, None])[None, :, None, :]
        forced = ((j_slc[None, :] == 0) | (j_slc[None, :] == blk_t[:, None]))[None, :, None, :]
        imp = jnp.where(forced, jnp.inf, jnp.where(causal_blk, imp, -jnp.inf))
        _, sel = lax.top_k(imp, top)
        k_sel = ks_blk[b_ix, g_ix, sel].reshape(bn, Q_BLOCK, G, top * SLC_BLOCK, Dh)
        v_sel = vs_blk[b_ix, g_ix, sel].reshape(bn, Q_BLOCK, G, top * SLC_BLOCK, Dh)
        kpos = (sel[..., None] * SLC_BLOCK + jnp.arange(SLC_BLOCK)).reshape(bn, Q_BLOCK, G, top * SLC_BLOCK)
        mask_s = (kpos <= t[None, :, None, None])[:, :, :, None, :]
        s_s = jnp.einsum('bqgrd,bqgnd->bqgrn', qb, k_sel).astype(jnp.float32) * scale
        p_s = jax.nn.softmax(jnp.where(mask_s, s_s, -jnp.inf), axis=-1)
        o_s = jnp.einsum('bqgrn,bqgnd->bqgrd', p_s.astype(v_sel.dtype), v_sel)
        k_w = lax.dynamic_slice_in_dim(kw_pad, s0, WINDOW + Q_BLOCK, axis=1)
        v_w = lax.dynamic_slice_in_dim(vw_pad, s0, WINDOW + Q_BLOCK, axis=1)
        wpos = s0 - WINDOW + jnp.arange(WINDOW + Q_BLOCK)
        mask_w = ((wpos[None, :] <= t[:, None]) & (wpos[None, :] > t[:, None] - WINDOW)
                  & (wpos[None, :] >= 0))[None, :, None, None, :]
        s_w = jnp.einsum('bqgrd,bngd->bqgrn', qb, k_w).astype(jnp.float32) * scale
        p_w = jax.nn.softmax(jnp.where(mask_w, s_w, -jnp.inf), axis=-1)
        o_w = jnp.einsum('bqgrn,bngd->bqgrd', p_w.astype(v_w.dtype), v_w)
        gc = jax.nn.sigmoid(gb)
        return gc[..., 0:1] * o_c + gc[..., 1:2] * o_s + gc[..., 2:3] * o_w

    out = lax.map(block, (q_b, g_b, starts))
    return jnp.moveaxis(out, 0, 1).reshape(bn, s, NSA_HEADS * Dh)


def _s5(u, a_re, a_im, b_re, b_im, c_re, c_im, d, log_dt, glu_w, glu_b):
    f32 = jnp.float32
    bn, s = u.shape[:2]
    uf = u.astype(f32).reshape(bn, s, S5_GROUPS, S5_GROUP_CH)
    A = lax.complex(a_re.astype(f32), a_im.astype(f32))
    dt = jnp.exp(log_dt.astype(f32))[:, None]
    A_bar = jnp.exp(A * dt)
    Bm = lax.complex(b_re.astype(f32), b_im.astype(f32))
    B_bar = ((A_bar - 1.0) / A)[..., None] * Bm
    Bu = jnp.einsum('bsgc,gpc->bsgp', uf.astype(jnp.complex64), B_bar)
    A_seq = jnp.broadcast_to(A_bar, Bu.shape)

    def combine(e1, e2):
        a1, b1 = e1
        a2, b2 = e2
        return a2 * a1, a2 * b1 + b2

    _, state = lax.associative_scan(combine, (A_seq, Bu), axis=1)
    Cm = lax.complex(c_re.astype(f32), c_im.astype(f32))
    y = jnp.einsum('bsgp,gcp->bsgc', state, Cm).real + d.astype(f32) * uf
    y = jax.nn.gelu(y.reshape(bn, s, BRANCH_W))
    y = y * jax.nn.sigmoid(y @ glu_w.astype(f32) + glu_b.astype(f32))
    return y.astype(u.dtype)


def _token_shift(t, mu):
    prev = jnp.pad(t, ((0, 0), (1, 0), (0, 0)))[:, :-1]
    return t + (prev - t) * mu


def _rwkv7(mix, w0, w2, a0, a2, k_k, k_a, r_k, ln_w, ln_b):
    f32 = jnp.float32
    out_dtype = mix.dtype
    bn, s = mix.shape[:2]
    H, N = RWKV_HEADS, HEAD_DIM
    r, k, v, wl, al = _split(mix.astype(f32), (BRANCH_W, BRANCH_W, BRANCH_W, DECAY_LORA, AAA_LORA))
    w = -jax.nn.softplus(-(w0.astype(f32) + jnp.tanh(wl) @ w2.astype(f32))) - 0.5
    decay = jnp.exp(-jnp.exp(w))
    a = jax.nn.sigmoid(a0.astype(f32) + al @ a2.astype(f32))
    kk = (k * k_k.astype(f32)).reshape(bn, s, H, N)
    kk = kk / jnp.maximum(jnp.sqrt(jnp.sum(kk * kk, axis=-1, keepdims=True)), 1e-12)
    k = k * (1.0 + (a - 1.0) * k_a.astype(f32))
    heads = lambda t: t.reshape(bn, s, H, N)
    r_h, k_h, v_h, w_h, a_h = heads(r), heads(k), heads(v), heads(decay), heads(a)
    aa = -kk
    bb = kk * a_h

    def step(state, inp):
        r_t, w_t, k_t, v_t, a_t, b_t = inp
        sa = jnp.einsum('bhvk,bhk->bhv', state, a_t)
        state = (state * w_t[:, :, None, :] + sa[..., None] * b_t[:, :, None, :]
                 + v_t[..., None] * k_t[:, :, None, :])
        return state, jnp.einsum('bhvk,bhk->bhv', state, r_t)

    xs = tuple(jnp.moveaxis(t, 1, 0) for t in (r_h, w_h, k_h, v_h, aa, bb))
    _, y = lax.scan(step, jnp.zeros((bn, H, N, N), f32), xs)
    y = jnp.moveaxis(y, 0, 1)
    mean = jnp.mean(y, axis=-1, keepdims=True)
    var = jnp.mean(jnp.square(y - mean), axis=-1, keepdims=True)
    y = ((y - mean) * lax.rsqrt(var + RWKV_LN_EPS)).reshape(bn, s, BRANCH_W)
    y = y * ln_w.astype(f32) + ln_b.astype(f32)
    bonus = jnp.sum(r_h * k_h * r_k.astype(f32).reshape(H, N), axis=-1, keepdims=True) * v_h
    return (y + bonus.reshape(bn, s, BRANCH_W)).astype(out_dtype)


def setup_inputs(seed: int = 0) -> dict:
    key = jax.random.key(seed)
    keys = iter(jax.random.split(key, 40))
    f32 = jnp.float32
    L, D, W = DEPTH, D_MODEL, BRANCH_W
    G, P, C = S5_GROUPS, S5_STATE, S5_GROUP_CH
    nrm = lambda shape, std: std * jax.random.normal(next(keys), shape, f32)
    unif = lambda shape, lo, hi: jax.random.uniform(next(keys), shape, f32, lo, hi)
    return {
        "x": nrm((BATCH, SEQ, D), 1.0),
        "c": nrm((BATCH, D), 1.0),
        "norm_w": 1.0 + nrm((L, D), 0.02),
        "mod_w": nrm((L, D, 3 * D), 0.5 * D ** -0.5),
        "mod_b": nrm((L, 3 * D), 0.01),
        "w_in": nrm((L, D, IN_W), D ** -0.5),
        "cmp_pos_k": nrm((L, CMP_BLOCK, HEAD_DIM), 0.1),
        "cmp_pos_v": nrm((L, CMP_BLOCK, HEAD_DIM), 0.1),
        "cmp_w1_k": nrm((L, CMP_BLOCK * HEAD_DIM, CMP_HIDDEN), (CMP_BLOCK * HEAD_DIM) ** -0.5),
        "cmp_w2_k": nrm((L, CMP_HIDDEN, HEAD_DIM), CMP_HIDDEN ** -0.5),
        "cmp_w1_v": nrm((L, CMP_BLOCK * HEAD_DIM, CMP_HIDDEN), (CMP_BLOCK * HEAD_DIM) ** -0.5),
        "cmp_w2_v": nrm((L, CMP_HIDDEN, HEAD_DIM), CMP_HIDDEN ** -0.5),
        "s5_a_re": -0.5 + nrm((L, G, P), 0.01),
        "s5_a_im": math.pi * jnp.broadcast_to(jnp.arange(P, dtype=f32), (L, G, P)) + nrm((L, G, P), 0.01),
        "s5_b_re": nrm((L, G, P, C), (2.0 * C) ** -0.5),
        "s5_b_im": nrm((L, G, P, C), (2.0 * C) ** -0.5),
        "s5_c_re": nrm((L, G, C, P), (2.0 * P) ** -0.5),
        "s5_c_im": nrm((L, G, C, P), (2.0 * P) ** -0.5),
        "s5_d": nrm((L, G, C), 0.5),
        "s5_log_dt": unif((L, G), math.log(1e-3), math.log(1e-1)),
        "s5_glu_w": nrm((L, W, W), W ** -0.5),
        "s5_glu_b": nrm((L, W), 0.01),
        "rwkv_mu": unif((L, RWKV_MIX_W), 0.0, 1.0),
        "rwkv_w0": unif((L, W), -6.0, -1.0),
        "rwkv_w2": nrm((L, DECAY_LORA, W), 0.5 * DECAY_LORA ** -0.5),
        "rwkv_a0": nrm((L, W), 0.1),
        "rwkv_a2": nrm((L, AAA_LORA, W), 0.5 * AAA_LORA ** -0.5),
        "rwkv_k_k": 0.85 + nrm((L, W), 0.02),
        "rwkv_k_a": 1.0 + nrm((L, W), 0.02),
        "rwkv_r_k": nrm((L, W), 0.1),
        "rwkv_ln_w": 1.0 + nrm((L, W), 0.02),
        "rwkv_ln_b": nrm((L, W), 0.01),
        "w_up": nrm((L, N_BRANCH, W, D), W ** -0.5),
        "w_out": nrm((L, D, D), D ** -0.5),
        "final_norm_w": 1.0 + nrm((D,), 0.02),
    }


def reference(x, c, norm_w, mod_w, mod_b, w_in, cmp_pos_k, cmp_pos_v, cmp_w1_k, cmp_w2_k,
              cmp_w1_v, cmp_w2_v, s5_a_re, s5_a_im, s5_b_re, s5_b_im, s5_c_re, s5_c_im, s5_d,
              s5_log_dt, s5_glu_w, s5_glu_b, rwkv_mu, rwkv_w0, rwkv_w2, rwkv_a0, rwkv_a2,
              rwkv_k_k, rwkv_k_a, rwkv_r_k, rwkv_ln_w, rwkv_ln_b, w_up, w_out, final_norm_w):
    bn, s, d = x.shape
    G, Dh = NSA_KV_GROUPS, HEAD_DIM
    cos, sin = _rope_tables(s)
    cond = jax.nn.silu(c)
    for l in range(DEPTH):
        shift, scale, gate = jnp.split(cond @ mod_w[l] + mod_b[l], 3, axis=-1)
        h = _rmsnorm(x, norm_w[l]) * (1.0 + scale[:, None, :]) + shift[:, None, :]
        proj = h @ w_in[l]
        q, kv, nsa_g, nsa_gate, s5_u, s5_gate, rwkv_mix, rwkv_gate, merge_g = _split(proj, IN_SPLITS)
        q = _rope(q.reshape(bn, s, NSA_HEADS, Dh), cos, sin)
        kc, vc, ks, vs, kw, vw = [t.reshape(bn, s, G, Dh) for t in jnp.split(kv, 6, axis=-1)]
        kc, ks, kw = _rope(kc, cos, sin), _rope(ks, cos, sin), _rope(kw, cos, sin)
        o_nsa = _nsa(q, kc, vc, ks, vs, kw, vw, nsa_g, cmp_pos_k[l], cmp_pos_v[l],
                     cmp_w1_k[l], cmp_w2_k[l], cmp_w1_v[l], cmp_w2_v[l])
        o_s5 = _s5(s5_u, s5_a_re[l], s5_a_im[l], s5_b_re[l], s5_b_im[l], s5_c_re[l], s5_c_im[l],
                   s5_d[l], s5_log_dt[l], s5_glu_w[l], s5_glu_b[l])
        o_rwkv = _rwkv7(_token_shift(rwkv_mix, rwkv_mu[l]), rwkv_w0[l], rwkv_w2[l], rwkv_a0[l],
                        rwkv_a2[l], rwkv_k_k[l], rwkv_k_a[l], rwkv_r_k[l], rwkv_ln_w[l], rwkv_ln_b[l])
        branches = jnp.stack([o_nsa * jax.nn.silu(nsa_gate), o_s5 * jax.nn.silu(s5_gate),
                              o_rwkv * jax.nn.silu(rwkv_gate)], axis=2)
        up = jnp.einsum('bsnw,nwd->bsnd', branches, w_up[l])
        merged = jnp.sum(jax.nn.sigmoid(merge_g.reshape(bn, s, N_BRANCH, d)) * up, axis=2)
        x = x + gate[:, None, :] * (merged @ w_out[l])
    return _rmsnorm(x, final_norm_w)
```

```cpp
#include <hip/hip_runtime.h>
#include <hip/hip_cooperative_groups.h>
#include <stdint.h>
#include <stdio.h>
namespace cg = cooperative_groups;

#ifndef MEGA
#define MEGA 1
#endif

typedef unsigned short bf16_t;
typedef __attribute__((ext_vector_type(8))) short bf16x8;
typedef __attribute__((ext_vector_type(16))) float f32x16;
typedef __attribute__((ext_vector_type(4))) float f32x4;

#define SEQ 4096
#define NTOK 32768
#define MIB ((size_t)1 << 20)

struct Params { const float* in[35]; float* out; char* ws; };

#define OFF_WT_IN(l)  ((size_t)(l) * 16 * MIB)
#define OFF_WT_UP(l)  (32 * MIB + (size_t)(l) * 3 * MIB)
#define OFF_WT_OUT(l) (38 * MIB + (size_t)(l) * 2 * MIB)
#define OFF_WT_GLU(l) (42 * MIB + (size_t)(l) * (MIB / 2))
#define OFF_WT_C1K(l) (43 * MIB + (size_t)(l) * MIB)
#define OFF_WT_C1V(l) (45 * MIB + (size_t)(l) * MIB)
#define OFF_WT_C2K(l) (47 * MIB + (size_t)(l) * 65536)
#define OFF_WT_C2V(l) (47 * MIB + 131072 + (size_t)(l) * 65536)
#define OFF_WT_LW(l)  (47 * MIB + 262144 + (size_t)(l) * 65536)
#define OFF_WT_LA(l)  (47 * MIB + 393216 + (size_t)(l) * 65536)
#define OFF_ROPE_C    (47 * MIB + 524288)
#define OFF_ROPE_S    (48 * MIB)
#define OFF_MOD       (48 * MIB + 524288)
#define OFF_S5AB      (48 * MIB + 786432)
#define OFF_S5BB      (48 * MIB + 786432 + 65536)
#define OFF_Q     (50 * MIB)
#define OFF_H2    (50 * MIB)
#define OFF_KS    (82 * MIB)
#define OFF_KW    (90 * MIB)
#define OFF_VST   (98 * MIB)
#define OFF_VWT   (106 * MIB)
#define OFF_KC    (114 * MIB)
#define OFF_VC    (122 * MIB)
#define OFF_NSAG  (130 * MIB)
#define OFF_S5U   (134 * MIB)
#define OFF_GATES (166 * MIB)
#define OFF_MIX   (262 * MIB)
#define OFF_MERGED (262 * MIB)
#define OFF_WLOG  (366 * MIB)
#define OFF_H1    (366 * MIB)
#define OFF_AA    (398 * MIB)
#define OFF_S5Y   (430 * MIB)
#define OFF_YRAW  (462 * MIB)
#define OFF_CMPHK (494 * MIB)
#define OFF_CMPHV (496 * MIB)
#define OFF_KCMP  (498 * MIB)
#define OFF_VCMPT (498 * MIB + 524288)
#define OFF_KNORM (500 * MIB)
#define OFF_XBAR (503 * MIB)
#define WS_NEEDED (504 * MIB)

#define SMEM_BYTES 78848
#define QSCALE 0.18033688011112042f

__device__ __forceinline__ int otid() { int t = threadIdx.x; asm volatile("" : "+v"(t)); return t; }
typedef __bf16 hbf2 __attribute__((ext_vector_type(2)));
typedef float hf2 __attribute__((ext_vector_type(2)));
__device__ __forceinline__ uint32_t pk2(float a, float b) {
  hf2 v = {a, b};
  return __builtin_bit_cast(uint32_t, __builtin_convertvector(v, hbf2));
}
__device__ __forceinline__ bf16_t f2bf(float f) { return (bf16_t)(pk2(f, 0.f) & 0xffffu); }
__device__ __forceinline__ float bf2f(bf16_t b) { return __uint_as_float(((uint32_t)b) << 16); }
__device__ __forceinline__ float lo_bf(uint32_t v) { return __uint_as_float(v << 16); }
__device__ __forceinline__ float hi_bf(uint32_t v) { return __uint_as_float(v & 0xffff0000u); }
__device__ __forceinline__ float sigmoidf_(float x) { return 1.f / (1.f + __expf(-x)); }
__device__ __forceinline__ float siluf_(float x) { return x / (1.f + __expf(-x)); }
__device__ __forceinline__ float tanhf_(float x) {
  float e = __expf(-2.f * fabsf(x));
  float t = (1.f - e) / (1.f + e);
  return x < 0.f ? -t : t;
}
__device__ __forceinline__ float geluf_(float x) {
  float u = 0.7978845608028654f * (x + 0.044715f * x * x * x);
  return 0.5f * x * (1.f + tanhf_(u));
}
__device__ __forceinline__ float ex2(float x) { return __builtin_amdgcn_exp2f(x); }
__device__ __forceinline__ float wave_sum_x(float x) {
#pragma unroll
  for (int o = 32; o > 0; o >>= 1) x += __shfl_xor(x, o);
  return x;
}
__device__ __forceinline__ float dpp_ror(float x, int) { return x; }
#define DPP_ADD(x, ctrl) x += __builtin_bit_cast(float, __builtin_amdgcn_update_dpp(0, __builtin_bit_cast(int, x), ctrl, 0xf, 0xf, false))
__device__ __forceinline__ float rr16(float x) {
  DPP_ADD(x, 0x128);
  DPP_ADD(x, 0x124);
  DPP_ADD(x, 0x122);
  DPP_ADD(x, 0x121);
  return x;
}
__device__ __forceinline__ float rr8(float x) {
  DPP_ADD(x, 0xB1);
  DPP_ADD(x, 0x4E);
  DPP_ADD(x, 0x141);
  return x;
}
__device__ __forceinline__ float wave_sum_d(float x) {
  x = rr16(x);
  int xi = __builtin_bit_cast(int, x);
  float s0 = __builtin_bit_cast(float, __builtin_amdgcn_readlane(xi, 0));
  float s1 = __builtin_bit_cast(float, __builtin_amdgcn_readlane(xi, 16));
  float s2 = __builtin_bit_cast(float, __builtin_amdgcn_readlane(xi, 32));
  float s3 = __builtin_bit_cast(float, __builtin_amdgcn_readlane(xi, 48));
  return (s0 + s1) + (s2 + s3);
}
__device__ __forceinline__ f32x16 mfma32(bf16x8 a, bf16x8 b, f32x16 c) {
  return __builtin_amdgcn_mfma_f32_32x32x16_bf16(a, b, c, 0, 0, 0);
}
__device__ __forceinline__ f32x4 mfma16(bf16x8 a, bf16x8 b, f32x4 c) {
  return __builtin_amdgcn_mfma_f32_16x16x32_bf16(a, b, c, 0, 0, 0);
}
__device__ __forceinline__ bf16x8 u4_to_frag(uint4 v) { return __builtin_bit_cast(bf16x8, v); }
__device__ __forceinline__ bf16x8 pack_frag(float a0, float a1, float a2, float a3, float a4, float a5, float a6, float a7) {
  uint4 v; v.x = pk2(a0, a1); v.y = pk2(a2, a3); v.z = pk2(a4, a5); v.w = pk2(a6, a7);
  return __builtin_bit_cast(bf16x8, v);
}

__device__ __forceinline__ void sincos_d(double x, double& s, double& c) {
  double rev = x * 0.15915494309189535;
  double fr = rev - rint(rev);
  double y = fr * 6.283185307179586 * 0.125;
  double y2 = y * y;
  s = y * (1.0 + y2 * (-1.0 / 6.0 + y2 * (1.0 / 120.0 + y2 * (-1.0 / 5040.0 + y2 * (1.0 / 362880.0 + y2 * (-1.0 / 39916800.0 + y2 * (1.0 / 6227020800.0)))))));
  c = 1.0 + y2 * (-0.5 + y2 * (1.0 / 24.0 + y2 * (-1.0 / 720.0 + y2 * (1.0 / 40320.0 + y2 * (-1.0 / 3628800.0 + y2 * (1.0 / 479001600.0 + y2 * (-1.0 / 87178291200.0)))))));
#pragma unroll
  for (int i = 0; i < 3; ++i) { double s2 = 2.0 * s * c, c2 = c * c - s * s; s = s2; c = c2; }
}

template <int NTW, bool SB = false, class AL, class BL>
__device__ __forceinline__ void gemm_loop(AL al, BL bl, int K, f32x16 (&acc)[2][NTW], char* smem) {
  const int tid = otid(), lane = tid & 63, wave = tid >> 6;
  const int wm = wave >> 1, wn = wave & 1, r = lane & 31, h = lane >> 5;
  uint4 ra0[4], rb0[4], ra1[4], rb1[4];
  const int nk = K >> 6;
  auto gload = [&](int kt, uint4 (&ra)[4], uint4 (&rb)[4]) __attribute__((always_inline)) {
    const int k0 = kt * 64;
#pragma unroll
    for (int i = 0; i < 4; ++i) {
      int id = tid + 256 * i;
      ra[i] = al(id >> 3, k0 + (id & 7) * 8);
      if (i < 2 * NTW) rb[i] = bl(id >> 3, k0 + (id & 7) * 8);
    }
  };
  auto lwrite = [&](int buf, uint4 (&ra)[4], uint4 (&rb)[4]) __attribute__((always_inline)) {
    bf16_t* As = (bf16_t*)smem + buf * (256 * 72);
    bf16_t* Bs = As + 128 * 72;
#pragma unroll
    for (int i = 0; i < 4; ++i) {
      int id = tid + 256 * i;
      *(uint4*)&As[(id >> 3) * 72 + (id & 7) * 8] = ra[i];
      if (i < 2 * NTW) *(uint4*)&Bs[(id >> 3) * 72 + (id & 7) * 8] = rb[i];
    }
  };
  auto compute = [&](int buf) __attribute__((always_inline)) {
    const bf16_t* As = (const bf16_t*)smem + buf * (256 * 72);
    const bf16_t* Bs = As + 128 * 72;
#pragma unroll
    for (int ks = 0; ks < 4; ++ks) {
      bf16x8 a0 = *(const bf16x8*)&As[(wm * 64 + r) * 72 + ks * 16 + h * 8];
      bf16x8 a1 = *(const bf16x8*)&As[(wm * 64 + 32 + r) * 72 + ks * 16 + h * 8];
#pragma unroll
      for (int nt = 0; nt < NTW; ++nt) {
        bf16x8 b0 = *(const bf16x8*)&Bs[(wn * 32 * NTW + nt * 32 + r) * 72 + ks * 16 + h * 8];
        acc[0][nt] = mfma32(a0, b0, acc[0][nt]);
        acc[1][nt] = mfma32(a1, b0, acc[1][nt]);
      }
    }
  };
  if (SB) {
    gload(0, ra0, rb0);
    for (int kt = 0; kt < nk; ++kt) {
      __syncthreads();
      lwrite(0, ra0, rb0);
      __syncthreads();
      gload(min(kt + 1, nk - 1), ra0, rb0);
      compute(0);
    }
    return;
  }
  gload(0, ra0, rb0);
  gload(min(1, nk - 1), ra1, rb1);
  __syncthreads();
  lwrite(0, ra0, rb0);
  __syncthreads();
  for (int kt = 0; kt < nk; kt += 2) {
    gload(min(kt + 2, nk - 1), ra0, rb0);
    compute(0);
    if (kt + 1 < nk) lwrite(1, ra1, rb1);
    __syncthreads();
    if (kt + 1 < nk) {
      gload(min(kt + 3, nk - 1), ra1, rb1);
      compute(1);
      if (kt + 2 < nk) lwrite(0, ra0, rb0);
      __syncthreads();
    }
  }
}
template <class AL, class BL>
__device__ __forceinline__ void gemm_loop_big(AL al, BL bl, int K, f32x16 (&acc)[4][2], char* smem) {
  const int tid = otid(), lane = tid & 63, wave = tid >> 6;
  const int wm = wave >> 1, wn = wave & 1, r = lane & 31, h = lane >> 5;
  bf16_t* As = (bf16_t*)smem;
  bf16_t* Bs = As + 256 * 72;
  uint4 ra[8], rb[4];
  const int nk = K >> 6;
#pragma unroll
  for (int i = 0; i < 8; ++i) { int id = tid + 256 * i; ra[i] = al(id >> 3, (id & 7) * 8); }
#pragma unroll
  for (int i = 0; i < 4; ++i) { int id = tid + 256 * i; rb[i] = bl(id >> 3, (id & 7) * 8); }
  for (int kt = 0; kt < nk; ++kt) {
    __syncthreads();
#pragma unroll
    for (int i = 0; i < 8; ++i) { int id = tid + 256 * i; *(uint4*)&As[(id >> 3) * 72 + (id & 7) * 8] = ra[i]; }
#pragma unroll
    for (int i = 0; i < 4; ++i) { int id = tid + 256 * i; *(uint4*)&Bs[(id >> 3) * 72 + (id & 7) * 8] = rb[i]; }
    __syncthreads();
    {
      const int k0 = min(kt + 1, nk - 1) * 64;
#pragma unroll
      for (int i = 0; i < 8; ++i) { int id = tid + 256 * i; ra[i] = al(id >> 3, k0 + (id & 7) * 8); }
#pragma unroll
      for (int i = 0; i < 4; ++i) { int id = tid + 256 * i; rb[i] = bl(id >> 3, k0 + (id & 7) * 8); }
    }
#pragma unroll
    for (int ks = 0; ks < 4; ++ks) {
      bf16x8 b0 = *(const bf16x8*)&Bs[(wn * 64 + r) * 72 + ks * 16 + h * 8];
      bf16x8 b1 = *(const bf16x8*)&Bs[(wn * 64 + 32 + r) * 72 + ks * 16 + h * 8];
#pragma unroll
      for (int mt = 0; mt < 4; ++mt) {
        bf16x8 a = *(const bf16x8*)&As[(wm * 128 + mt * 32 + r) * 72 + ks * 16 + h * 8];
        acc[mt][0] = mfma32(a, b0, acc[mt][0]);
        acc[mt][1] = mfma32(a, b1, acc[mt][1]);
      }
    }
  }
}
template <int NTW>
__device__ __forceinline__ void zero_acc(f32x16 (&acc)[2][NTW]) {
#pragma unroll
  for (int a = 0; a < 2; ++a)
#pragma unroll
    for (int b = 0; b < NTW; ++b)
#pragma unroll
      for (int i = 0; i < 16; ++i) acc[a][b][i] = 0.f;
}
template <int MT, class EP>
__device__ __forceinline__ void gemm_epi(f32x16 (&acc)[MT][2], int m0, int n0, EP ep) {
  const int lane = otid() & 63, wave = otid() >> 6;
  const int wm = wave >> 1, wn = wave & 1, r = lane & 31, h = lane >> 5;
#pragma unroll
  for (int mt = 0; mt < MT; ++mt)
#pragma unroll
    for (int qd = 0; qd < 4; ++qd) {
      int row0 = m0 + wm * (MT * 32) + mt * 32 + 8 * qd + 4 * h;
      int col = n0 + wn * 64 + r;
      ep(row0, col, acc[mt][0][4 * qd], acc[mt][0][4 * qd + 1], acc[mt][0][4 * qd + 2], acc[mt][0][4 * qd + 3],
         acc[mt][1][4 * qd], acc[mt][1][4 * qd + 1], acc[mt][1][4 * qd + 2], acc[mt][1][4 * qd + 3]);
    }
}

__device__ __forceinline__ int win_map(int n2) {
  if (n2 < 1280) return n2;
  if (n2 < 1792) return 1304 + (n2 - 1280);
  if (n2 < 2304) return 2328 + (n2 - 1792);
  if (n2 < 2816) return 4504 + (n2 - 2304);
  if (n2 < 3328) return 1816 + (n2 - 2816);
  if (n2 < 4992) return 2840 + (n2 - 3328);
  if (n2 < 5016) return 1280 + (n2 - 4992);
  if (n2 < 5120) return -1;
  return 5016 + (n2 - 5120);
}
__device__ __forceinline__ void tconv(const float* __restrict__ src, int K, int Nsrc, bf16_t* dst, int Ndst, int mapkind, int gtid, int gsize) {
  int total = Ndst * (K >> 3);
  for (int idx = gtid; idx < total; idx += gsize) {
    int n2 = idx % Ndst, k8 = idx / Ndst;
    int n = mapkind ? win_map(n2) : (n2 < Nsrc ? n2 : -1);
    uint4 o = make_uint4(0, 0, 0, 0);
    if (n >= 0) {
      const float* s = src + (size_t)(k8 * 8) * Nsrc + n;
      float v0 = s[0], v1 = s[Nsrc], v2 = s[2 * (size_t)Nsrc], v3 = s[3 * (size_t)Nsrc];
      float v4 = s[4 * (size_t)Nsrc], v5 = s[5 * (size_t)Nsrc], v6 = s[6 * (size_t)Nsrc], v7 = s[7 * (size_t)Nsrc];
      o.x = pk2(v0, v1); o.y = pk2(v2, v3); o.z = pk2(v4, v5); o.w = pk2(v6, v7);
    }
    *(uint4*)(dst + (size_t)n2 * K + k8 * 8) = o;
  }
}

__device__ __forceinline__ void phase_prep(const Params& p, char* smem) {
  const int tid = otid();
  const int gtid = blockIdx.x * 256 + tid, gsize = gridDim.x * 256;
  char* ws = p.ws;
  for (int task = blockIdx.x; task < 96; task += gridDim.x) {
    float* cond = (float*)smem;
    float* red = cond + 8192;
    __syncthreads();
    for (int i = tid; i < 8192; i += 256) cond[i] = siluf_(p.in[1][i]);
    __syncthreads();
    int l = task / 48, cg_ = task % 48;
    int kc = tid >> 6, n = tid & 63, col = cg_ * 64 + n;
    float a[8];
#pragma unroll
    for (int b = 0; b < 8; ++b) a[b] = 0.f;
    const float* mw = p.in[3] + (size_t)l * 1024 * 3072 + col;
    for (int k = kc * 256; k < kc * 256 + 256; ++k) {
      float w = mw[(size_t)k * 3072];
#pragma unroll
      for (int b = 0; b < 8; ++b) a[b] += cond[b * 1024 + k] * w;
    }
#pragma unroll
    for (int b = 0; b < 8; ++b) red[(kc * 8 + b) * 64 + n] = a[b];
    __syncthreads();
    for (int i = tid; i < 512; i += 256) {
      int b = i >> 6, nn = i & 63;
      float v = red[(0 * 8 + b) * 64 + nn] + red[(1 * 8 + b) * 64 + nn] + red[(2 * 8 + b) * 64 + nn] + red[(3 * 8 + b) * 64 + nn];
      int cc = cg_ * 64 + nn;
      ((float*)(ws + OFF_MOD))[(size_t)(l * 8 + b) * 3072 + cc] = v + p.in[4][l * 3072 + cc];
    }
  }
  for (int idx = gtid; idx < 4096 * 32; idx += gsize) {
    int s = idx >> 5, d = idx & 31;
    float inv = expf(-9.210340371976184f * (float)d / 32.f);
    double ang = (double)s * (double)inv, sn, cs;
    sincos_d(ang, sn, cs);
    ((float*)(ws + OFF_ROPE_C))[idx] = (float)cs;
    ((float*)(ws + OFF_ROPE_S))[idx] = (float)sn;
  }
  for (int idx = gtid; idx < 2 * 32 * 64; idx += gsize) {
    int l = idx >> 11, g = (idx >> 6) & 31, pp = idx & 63;
    double are = p.in[12][idx], aim = p.in[13][idx];
    double dt = exp((double)p.in[19][l * 32 + g]);
    double mag = exp(are * dt), sn, cs;
    sincos_d(aim * dt, sn, cs);
    double abr = mag * cs, abi = mag * sn;
    ((float*)(ws + OFF_S5AB))[idx * 2] = (float)abr;
    ((float*)(ws + OFF_S5AB))[idx * 2 + 1] = (float)abi;
    double nr = abr - 1.0, ni = abi, den = are * are + aim * aim;
    double cr = (nr * are + ni * aim) / den, ci = (ni * are - nr * aim) / den;
    bf16_t* bb = (bf16_t*)(ws + OFF_S5BB) + (size_t)(l * 32 + g) * 2 * 64 * 16;
    for (int c = 0; c < 16; ++c) {
      double br = p.in[14][(size_t)idx * 16 + c], bi = p.in[15][(size_t)idx * 16 + c];
      bb[(0 * 64 + pp) * 16 + c] = f2bf((float)(cr * br - ci * bi));
      bb[(1 * 64 + pp) * 16 + c] = f2bf((float)(cr * bi + ci * br));
    }
  }
  for (int job = 0; job < 24; ++job) {
    const int l = job / 12, j = job % 12;
    const float* src; bf16_t* dst; int K, Nsrc, Ndst, mk = 0;
    switch (j) {
      case 0: src = p.in[5] + (size_t)l * 1024 * 8088; K = 1024; Nsrc = 8088; dst = (bf16_t*)(ws + OFF_WT_IN(l)); Ndst = 8192; mk = 1; break;
      case 1: case 2: case 3:
        src = p.in[32] + (size_t)(l * 3 + (j - 1)) * 512 * 1024; K = 512; Nsrc = 1024;
        dst = (bf16_t*)(ws + OFF_WT_UP(l)) + (size_t)(j - 1) * 1024 * 512; Ndst = 1024; break;
      case 4: src = p.in[33] + (size_t)l * 1024 * 1024; K = 1024; Nsrc = 1024; dst = (bf16_t*)(ws + OFF_WT_OUT(l)); Ndst = 1024; break;
      case 5: src = p.in[20] + (size_t)l * 512 * 512; K = 512; Nsrc = 512; dst = (bf16_t*)(ws + OFF_WT_GLU(l)); Ndst = 512; break;
      case 6: src = p.in[8] + (size_t)l * 2048 * 256; K = 2048; Nsrc = 256; dst = (bf16_t*)(ws + OFF_WT_C1K(l)); Ndst = 256; break;
      case 7: src = p.in[10] + (size_t)l * 2048 * 256; K = 2048; Nsrc = 256; dst = (bf16_t*)(ws + OFF_WT_C1V(l)); Ndst = 256; break;
      case 8: src = p.in[9] + (size_t)l * 256 * 64; K = 256; Nsrc = 64; dst = (bf16_t*)(ws + OFF_WT_C2K(l)); Ndst = 128; break;
      case 9: src = p.in[11] + (size_t)l * 256 * 64; K = 256; Nsrc = 64; dst = (bf16_t*)(ws + OFF_WT_C2V(l)); Ndst = 128; break;
      case 10: src = p.in[24] + (size_t)l * 64 * 512; K = 64; Nsrc = 512; dst = (bf16_t*)(ws + OFF_WT_LW(l)); Ndst = 512; break;
      default: src = p.in[26] + (size_t)l * 64 * 512; K = 64; Nsrc = 512; dst = (bf16_t*)(ws + OFF_WT_LA(l)); Ndst = 512; break;
    }
    tconv(src, K, Nsrc, dst, Ndst, mk, gtid, gsize);
  }
}

template <int R>
__device__ __forceinline__ void norm_rows(const Params& p, int l, int row0, bf16_t* H) {
  const int lane = otid() & 63;
  const float* xb = (l == 0 ? p.in[0] : p.out);
  float4 v[R][4];
  float ss[R];
#pragma unroll
  for (int u = 0; u < R; ++u) {
    const float* xs = xb + (size_t)(row0 + u) * 1024;
    ss[u] = 0.f;
#pragma unroll
    for (int i = 0; i < 4; ++i) v[u][i] = *(const float4*)(xs + lane * 4 + 256 * i);
  }
  const float* nw = p.in[2] + l * 1024;
#pragma unroll
  for (int u = 0; u < R; ++u) {
#pragma unroll
    for (int i = 0; i < 4; ++i) ss[u] += v[u][i].x * v[u][i].x + v[u][i].y * v[u][i].y + v[u][i].z * v[u][i].z + v[u][i].w * v[u][i].w;
    ss[u] = wave_sum_x(ss[u]);
    float rr = rsqrtf(ss[u] * (1.f / 1024.f) + 1e-6f);
    int b = (row0 + u) >> 12;
    const float* md = (const float*)(p.ws + OFF_MOD) + (size_t)(l * 8 + b) * 3072;
#pragma unroll
    for (int i = 0; i < 4; ++i) {
      int d = lane * 4 + 256 * i;
      float4 w = *(const float4*)(nw + d);
      float4 sh = *(const float4*)(md + d);
      float4 sc = *(const float4*)(md + 1024 + d);
      float h0 = v[u][i].x * rr * w.x * (1.f + sc.x) + sh.x;
      float h1 = v[u][i].y * rr * w.y * (1.f + sc.y) + sh.y;
      float h2 = v[u][i].z * rr * w.z * (1.f + sc.z) + sh.z;
      float h3 = v[u][i].w * rr * w.w * (1.f + sc.w) + sh.w;
      uint2 o; o.x = pk2(h0, h1); o.y = pk2(h2, h3);
      *(uint2*)(H + (size_t)(row0 + u) * 1024 + d) = o;
    }
  }
}
template <int R>
__device__ __forceinline__ void final_norm_rows(const Params& p, int row0) {
  const int lane = otid() & 63;
  float4 v[R][4];
#pragma unroll
  for (int u = 0; u < R; ++u)
#pragma unroll
    for (int i = 0; i < 4; ++i) v[u][i] = *(const float4*)(p.out + (size_t)(row0 + u) * 1024 + lane * 4 + 256 * i);
#pragma unroll
  for (int u = 0; u < R; ++u) {
    float ss = 0.f;
#pragma unroll
    for (int i = 0; i < 4; ++i) ss += v[u][i].x * v[u][i].x + v[u][i].y * v[u][i].y + v[u][i].z * v[u][i].z + v[u][i].w * v[u][i].w;
    ss = wave_sum_x(ss);
    float rr = rsqrtf(ss * (1.f / 1024.f) + 1e-6f);
#pragma unroll
    for (int i = 0; i < 4; ++i) {
      int d = lane * 4 + 256 * i;
      float4 w = *(const float4*)(p.in[34] + d);
      float4 o = make_float4(v[u][i].x * rr * w.x, v[u][i].y * rr * w.y, v[u][i].z * rr * w.z, v[u][i].w * rr * w.w);
      *(float4*)(p.out + (size_t)(row0 + u) * 1024 + d) = o;
    }
  }
}

__device__ __forceinline__ void proj_tile(const Params& p, int l, int tile, char* smem) {
  char* ws = p.ws;
  const int m0 = (tile / 40) * 256, n0 = (tile % 40) * 128;
  const bf16_t* A = (const bf16_t*)(ws + OFF_H1) + (size_t)m0 * 1024;
  const bf16_t* B = (const bf16_t*)(ws + OFF_WT_IN(l)) + (size_t)n0 * 1024;
  f32x16 acc[4][2];
#pragma unroll
  for (int a_ = 0; a_ < 4; ++a_)
#pragma unroll
    for (int b_ = 0; b_ < 2; ++b_)
#pragma unroll
      for (int i_ = 0; i_ < 16; ++i_) acc[a_][b_][i_] = 0.f;
  gemm_loop_big([=](int row, int k) __attribute__((always_inline)) { return *(const uint4*)(A + (uint32_t)(row * 1024 + k)); },
            [=](int row, int k) __attribute__((always_inline)) { return *(const uint4*)(B + (uint32_t)(row * 1024 + k)); }, 1024, acc, smem);
  const float* ropeC = (const float*)(ws + OFF_ROPE_C);
  const float* ropeS = (const float*)(ws + OFF_ROPE_S);
  const int lane = otid() & 63, wn = (otid() >> 6) & 1, r = lane & 31;
  if (n0 < 512) {
    bf16_t* Q = (bf16_t*)(ws + OFF_Q);
    const int wm_ = otid() >> 7, h_ = lane >> 5;
#pragma unroll
    for (int mt = 0; mt < 4; ++mt) {
      float rcs[4][4], rsn[4][4];
#pragma unroll
      for (int qd = 0; qd < 4; ++qd)
#pragma unroll
        for (int j = 0; j < 4; ++j) {
          int s_ = (m0 + wm_ * 128 + mt * 32 + 8 * qd + 4 * h_ + j) & 4095;
          rcs[qd][j] = ropeC[s_ * 32 + r];
          rsn[qd][j] = ropeS[s_ * 32 + r];
        }
#pragma unroll
      for (int qd = 0; qd < 4; ++qd)
#pragma unroll
        for (int j = 0; j < 4; ++j) {
          int row = m0 + wm_ * 128 + mt * 32 + 8 * qd + 4 * h_ + j, col = n0 + wn * 64 + r;
          float cs = rcs[qd][j], sn = rsn[qd][j];
          float a_ = acc[mt][0][4 * qd + j], b_ = acc[mt][1][4 * qd + j];
          Q[(size_t)row * 512 + col] = f2bf((a_ * cs - b_ * sn) * QSCALE);
          Q[(size_t)row * 512 + col + 32] = f2bf((a_ * sn + b_ * cs) * QSCALE);
        }
    }
  } else if (n0 < 1280) {
    const int part = (n0 - 512) >> 7, g = wn;
    if ((part & 1) == 0) {
      bf16_t* Kb = (bf16_t*)(ws + (part == 0 ? OFF_KC : (part == 2 ? OFF_KS : OFF_KW)));
      const int wm_ = otid() >> 7, h_ = lane >> 5;
#pragma unroll
      for (int mt = 0; mt < 4; ++mt) {
        float rcs[4][4], rsn[4][4];
#pragma unroll
        for (int qd = 0; qd < 4; ++qd)
#pragma unroll
          for (int j = 0; j < 4; ++j) {
            int s_ = (m0 + wm_ * 128 + mt * 32 + 8 * qd + 4 * h_ + j) & 4095;
            rcs[qd][j] = ropeC[s_ * 32 + r];
            rsn[qd][j] = ropeS[s_ * 32 + r];
          }
#pragma unroll
        for (int qd = 0; qd < 4; ++qd)
#pragma unroll
          for (int j = 0; j < 4; ++j) {
            int row = m0 + wm_ * 128 + mt * 32 + 8 * qd + 4 * h_ + j, s_ = row & 4095, b_i = row >> 12;
            float cs = rcs[qd][j], sn = rsn[qd][j];
            float a_ = acc[mt][0][4 * qd + j], b_ = acc[mt][1][4 * qd + j];
            size_t o = ((size_t)(b_i * 2 + g) * 4096 + s_) * 64 + r;
            Kb[o] = f2bf(a_ * cs - b_ * sn);
            Kb[o + 32] = f2bf(a_ * sn + b_ * cs);
          }
      }
    } else if (part == 1) {
      bf16_t* Vb = (bf16_t*)(ws + OFF_VC);
      gemm_epi(acc, m0, n0, [=](int row0, int col, float a0, float a1, float a2, float a3, float b0, float b1, float b2, float b3) __attribute__((always_inline)) {
        float av[4] = {a0, a1, a2, a3}, bv[4] = {b0, b1, b2, b3};
#pragma unroll
        for (int j = 0; j < 4; ++j) {
          int row = row0 + j, s = row & 4095, b = row >> 12;
          size_t o = ((size_t)(b * 2 + g) * 4096 + s) * 64 + r;
          Vb[o] = f2bf(av[j]);
          Vb[o + 32] = f2bf(bv[j]);
        }
      });
    } else {
      bf16_t* Vt = (bf16_t*)(ws + (part == 3 ? OFF_VST : OFF_VWT));
      gemm_epi(acc, m0, n0, [=](int row0, int col, float a0, float a1, float a2, float a3, float b0, float b1, float b2, float b3) __attribute__((always_inline)) {
        int s = row0 & 4095, b = row0 >> 12;
        size_t o = ((size_t)(b * 2 + g) * 64 + r) * 4096 + s;
        uint2 v; v.x = pk2(a0, a1); v.y = pk2(a2, a3);
        *(uint2*)(Vt + o) = v;
        uint2 w; w.x = pk2(b0, b1); w.y = pk2(b2, b3);
        *(uint2*)(Vt + o + (size_t)32 * 4096) = w;
      });
    }
  } else if (n0 < 2816) {
    bf16_t* G = (bf16_t*)(ws + OFF_GATES);
    gemm_epi(acc, m0, n0, [=](int row0, int col, float a0, float a1, float a2, float a3, float b0, float b1, float b2, float b3) __attribute__((always_inline)) {
      float av[4] = {a0, a1, a2, a3}, bv[4] = {b0, b1, b2, b3};
#pragma unroll
      for (int j = 0; j < 4; ++j) {
        size_t o = (size_t)(row0 + j) * 1536 + (col - 1280);
        G[o] = f2bf(siluf_(av[j]));
        G[o + 32] = f2bf(siluf_(bv[j]));
      }
    });
  } else if (n0 < 3328) {
    bf16_t* U = (bf16_t*)(ws + OFF_S5U);
    gemm_epi(acc, m0, n0, [=](int row0, int col, float a0, float a1, float a2, float a3, float b0, float b1, float b2, float b3) __attribute__((always_inline)) {
      float av[4] = {a0, a1, a2, a3}, bv[4] = {b0, b1, b2, b3};
#pragma unroll
      for (int j = 0; j < 4; ++j) {
        size_t o = (size_t)(row0 + j) * 512 + (col - 2816);
        U[o] = f2bf(av[j]);
        U[o + 32] = f2bf(bv[j]);
      }
    });
  } else if (n0 < 4992) {
    bf16_t* X = (bf16_t*)(ws + OFF_MIX);
    gemm_epi(acc, m0, n0, [=](int row0, int col, float a0, float a1, float a2, float a3, float b0, float b1, float b2, float b3) __attribute__((always_inline)) {
      float av[4] = {a0, a1, a2, a3}, bv[4] = {b0, b1, b2, b3};
#pragma unroll
      for (int j = 0; j < 4; ++j) {
        size_t o = (size_t)(row0 + j) * 1664 + (col - 3328);
        X[o] = f2bf(av[j]);
        X[o + 32] = f2bf(bv[j]);
      }
    });
  } else {
    float* NG = (float*)(ws + OFF_NSAG);
    gemm_epi(acc, m0, n0, [=](int row0, int col, float a0, float a1, float a2, float a3, float b0, float b1, float b2, float b3) __attribute__((always_inline)) {
      int c = col - 4992;
      if (c < 24) {
        NG[(size_t)(row0 + 0) * 32 + c] = a0;
        NG[(size_t)(row0 + 1) * 32 + c] = a1;
        NG[(size_t)(row0 + 2) * 32 + c] = a2;
        NG[(size_t)(row0 + 3) * 32 + c] = a3;
      }
    });
  }
}

__device__ __forceinline__ void cmp1_tile(const Params& p, int l, int tile, char* smem) {
  char* ws = p.ws;
  const int isv = tile >> 6, t2 = tile & 63;
  const int m0 = (t2 >> 1) * 128, n0 = (t2 & 1) * 128;
  const bf16_t* src = (const bf16_t*)(ws + (isv ? OFF_VC : OFF_KC));
  const float* pos = p.in[isv ? 7 : 6] + (size_t)l * 2048;
  const bf16_t* B = (const bf16_t*)(ws + (isv ? OFF_WT_C1V(l) : OFF_WT_C1K(l))) + (size_t)n0 * 2048;
  f32x16 acc[2][2];
  zero_acc<2>(acc);
  gemm_loop<2>(
      [=](int row, int k) __attribute__((always_inline)) {
        int R = m0 + row, bg = R >> 8, n = R & 255;
        uint4 o = make_uint4(0, 0, 0, 0);
        if (n < 255) {
          int j = k >> 6, d = k & 63;
          uint4 v = *(const uint4*)(src + ((size_t)bg * 4096 + 16 * n + j) * 64 + d);
          float4 p0 = *(const float4*)(pos + k), p1 = *(const float4*)(pos + k + 4);
          o.x = pk2(lo_bf(v.x) + p0.x, hi_bf(v.x) + p0.y);
          o.y = pk2(lo_bf(v.y) + p0.z, hi_bf(v.y) + p0.w);
          o.z = pk2(lo_bf(v.z) + p1.x, hi_bf(v.z) + p1.y);
          o.w = pk2(lo_bf(v.w) + p1.z, hi_bf(v.w) + p1.w);
        }
        return o;
      },
      [=](int row, int k) __attribute__((always_inline)) { return *(const uint4*)(B + (uint32_t)(row * 2048 + k)); }, 2048, acc, smem);
  bf16_t* Hd = (bf16_t*)(ws + (isv ? OFF_CMPHV : OFF_CMPHK));
  gemm_epi(acc, m0, n0, [=](int row0, int col, float a0, float a1, float a2, float a3, float b0, float b1, float b2, float b3) __attribute__((always_inline)) {
    float av[4] = {a0, a1, a2, a3}, bv[4] = {b0, b1, b2, b3};
#pragma unroll
    for (int j = 0; j < 4; ++j) {
      size_t o = (size_t)(row0 + j) * 256 + col;
      Hd[o] = f2bf(siluf_(av[j]));
      Hd[o + 32] = f2bf(siluf_(bv[j]));
    }
  });
}
__device__ __forceinline__ void cmp2_tile(const Params& p, int l, int tile, char* smem) {
  char* ws = p.ws;
  const int isv = tile >> 5, m0 = (tile & 31) * 128;
  const bf16_t* A = (const bf16_t*)(ws + (isv ? OFF_CMPHV : OFF_CMPHK)) + (size_t)m0 * 256;
  const bf16_t* B = (const bf16_t*)(ws + (isv ? OFF_WT_C2V(l) : OFF_WT_C2K(l)));
  f32x16 acc[2][2];
  zero_acc<2>(acc);
  gemm_loop<2>([=](int row, int k) __attribute__((always_inline)) { return *(const uint4*)(A + (uint32_t)(row * 256 + k)); },
            [=](int row, int k) __attribute__((always_inline)) { return *(const uint4*)(B + (uint32_t)(row * 256 + k)); }, 256, acc, smem);
  const int wn = (otid() >> 6) & 1;
  if (wn == 0) {
    if (!isv) {
      bf16_t* D = (bf16_t*)(ws + OFF_KCMP);
      gemm_epi(acc, m0, 0, [=](int row0, int col, float a0, float a1, float a2, float a3, float b0, float b1, float b2, float b3) __attribute__((always_inline)) {
        float av[4] = {a0, a1, a2, a3}, bv[4] = {b0, b1, b2, b3};
#pragma unroll
        for (int j = 0; j < 4; ++j) {
          D[(size_t)(row0 + j) * 64 + col] = f2bf(av[j]);
          D[(size_t)(row0 + j) * 64 + col + 32] = f2bf(bv[j]);
        }
      });
    } else {
      bf16_t* D = (bf16_t*)(ws + OFF_VCMPT);
      gemm_epi(acc, m0, 0, [=](int row0, int col, float a0, float a1, float a2, float a3, float b0, float b1, float b2, float b3) __attribute__((always_inline)) {
        int bg = row0 >> 8, n = row0 & 255;
        size_t o = ((size_t)bg * 64 + col) * 256 + n;
        uint2 v; v.x = pk2(a0, a1); v.y = pk2(a2, a3);
        *(uint2*)(D + o) = v;
        uint2 w; w.x = pk2(b0, b1); w.y = pk2(b2, b3);
        *(uint2*)(D + o + 32 * 256) = w;
      });
    }
  }
}

__device__ __forceinline__ void lora_tile(const Params& p, int l, int tile, char* smem) {
  char* ws = p.ws;
  const int isa = tile >> 10, t2 = tile & 1023;
  const int m0 = (t2 >> 2) * 128, n0 = (t2 & 3) * 128;
  const bf16_t* MX = (const bf16_t*)(ws + OFF_MIX);
  const float* mu = p.in[22] + (size_t)l * 1664 + (isa ? 1600 : 1536);
  const int coff = isa ? 1600 : 1536;
  const bf16_t* B = (const bf16_t*)(ws + (isa ? OFF_WT_LA(l) : OFF_WT_LW(l))) + (size_t)n0 * 64;
  f32x16 acc[2][2];
  zero_acc<2>(acc);
  gemm_loop<2>(
      [=](int row, int k) __attribute__((always_inline)) {
        int tok = m0 + row;
        uint4 c = *(const uint4*)(MX + (size_t)tok * 1664 + coff + k);
        uint4 pv = make_uint4(0, 0, 0, 0);
        if ((tok & 4095) != 0) pv = *(const uint4*)(MX + (size_t)(tok - 1) * 1664 + coff + k);
        float4 m0_ = *(const float4*)(mu + k), m1_ = *(const float4*)(mu + k + 4);
        float v[8];
        v[0] = lo_bf(c.x) + (lo_bf(pv.x) - lo_bf(c.x)) * m0_.x;
        v[1] = hi_bf(c.x) + (hi_bf(pv.x) - hi_bf(c.x)) * m0_.y;
        v[2] = lo_bf(c.y) + (lo_bf(pv.y) - lo_bf(c.y)) * m0_.z;
        v[3] = hi_bf(c.y) + (hi_bf(pv.y) - hi_bf(c.y)) * m0_.w;
        v[4] = lo_bf(c.z) + (lo_bf(pv.z) - lo_bf(c.z)) * m1_.x;
        v[5] = hi_bf(c.z) + (hi_bf(pv.z) - hi_bf(c.z)) * m1_.y;
        v[6] = lo_bf(c.w) + (lo_bf(pv.w) - lo_bf(c.w)) * m1_.z;
        v[7] = hi_bf(c.w) + (hi_bf(pv.w) - hi_bf(c.w)) * m1_.w;
        if (!isa) {
#pragma unroll
          for (int j = 0; j < 8; ++j) v[j] = tanhf_(v[j]);
        }
        uint4 o; o.x = pk2(v[0], v[1]); o.y = pk2(v[2], v[3]); o.z = pk2(v[4], v[5]); o.w = pk2(v[6], v[7]);
        return o;
      },
      [=](int row, int k) __attribute__((always_inline)) { return *(const uint4*)(B + (uint32_t)(row * 64 + k)); }, 64, acc, smem);
  if (!isa) {
    bf16_t* D = (bf16_t*)(ws + OFF_WLOG);
    const float* w0 = p.in[23] + l * 512;
    const int c_ = n0 + ((otid() >> 6) & 1) * 64 + (otid() & 31);
    const float wa = w0[c_], wb = w0[c_ + 32];
    gemm_epi(acc, m0, n0, [=](int row0, int col, float a0, float a1, float a2, float a3, float b0, float b1, float b2, float b3) __attribute__((always_inline)) {
      float av[4] = {a0, a1, a2, a3}, bv[4] = {b0, b1, b2, b3};
#pragma unroll
      for (int j = 0; j < 4; ++j) {
        float z = -(wa + av[j]);
        float sp = fmaxf(z, 0.f) + log1pf(__expf(-fabsf(z)));
        float ld = -__expf(-sp - 0.5f);
        D[(size_t)(row0 + j) * 512 + col] = f2bf(ld);
        z = -(wb + bv[j]);
        sp = fmaxf(z, 0.f) + log1pf(__expf(-fabsf(z)));
        ld = -__expf(-sp - 0.5f);
        D[(size_t)(row0 + j) * 512 + col + 32] = f2bf(ld);
      }
    });
  } else {
    bf16_t* D = (bf16_t*)(ws + OFF_AA);
    const float* a0p = p.in[25] + l * 512;
    const int c_ = n0 + ((otid() >> 6) & 1) * 64 + (otid() & 31);
    const float wa = a0p[c_], wb = a0p[c_ + 32];
    gemm_epi(acc, m0, n0, [=](int row0, int col, float a0, float a1, float a2, float a3, float b0, float b1, float b2, float b3) __attribute__((always_inline)) {
      float av[4] = {a0, a1, a2, a3}, bv[4] = {b0, b1, b2, b3};
#pragma unroll
      for (int j = 0; j < 4; ++j) {
        D[(size_t)(row0 + j) * 512 + col] = f2bf(sigmoidf_(wa + av[j]));
        D[(size_t)(row0 + j) * 512 + col + 32] = f2bf(sigmoidf_(wb + bv[j]));
      }
    });
  }
}

__device__ __forceinline__ void s5_scan(const Params& p, int l, int task, char* smem) {
  char* ws = p.ws;
  const int tid = otid(), lane = tid & 63, wave = tid >> 6;
  const int wt = task * 4 + wave, bp = wt >> 5, g = wt & 31;
  uint32_t* Xl = (uint32_t*)smem + wave * (2 * 16 * 68);
  const int r = lane & 31, hq = lane >> 5;
  const bf16_t* BBp = (const bf16_t*)(ws + OFF_S5BB) + (size_t)(l * 32 + g) * 2 * 64 * 16;
  bf16x8 bfr[4];
#pragma unroll
  for (int j = 0; j < 4; ++j) {
    int ri = j & 1, pp = r + 32 * (j >> 1);
    bfr[j] = *(const bf16x8*)(BBp + (ri * 64 + pp) * 16 + hq * 8);
  }
  const float* ABp = (const float*)(ws + OFF_S5AB) + (size_t)(l * 32 + g) * 128;
  const float a0r = ABp[r * 2], a0i = ABp[r * 2 + 1], a1r = ABp[(32 + r) * 2], a1i = ABp[(32 + r) * 2 + 1];
  const int c16 = lane & 15, q4 = lane >> 4;
  bf16x8 cfr[4];
  {
    const float* cre = p.in[16] + ((size_t)(l * 32 + g) * 16 + c16) * 64;
    const float* cim = p.in[17] + ((size_t)(l * 32 + g) * 16 + c16) * 64;
#pragma unroll
    for (int ks = 0; ks < 4; ++ks) {
      float v[8];
#pragma unroll
      for (int jj = 0; jj < 8; ++jj) {
        int pp = 16 * ks + 4 * q4 + (jj >> 1);
        v[jj] = (jj & 1) ? -cim[pp] : cre[pp];
      }
      cfr[ks] = pack_frag(v[0], v[1], v[2], v[3], v[4], v[5], v[6], v[7]);
    }
  }
  uint4* fragL = (uint4*)(smem + 34816) + wave * 512;
  __syncthreads();
#pragma unroll
  for (int j = 0; j < 4; ++j) { fragL[j * 64 + lane] = __builtin_bit_cast(uint4, bfr[j]); fragL[(4 + j) * 64 + lane] = __builtin_bit_cast(uint4, cfr[j]); }
  const float dcoef = p.in[18][(l * 32 + g) * 16 + c16];
  const int hb_row = (r >> 2) & 1, trow = (r & 3) + 4 * (r >> 3);
  const bf16_t* U = (const bf16_t*)(ws + OFF_S5U);
  bf16_t* Y = (bf16_t*)(ws + OFF_S5Y);
  const bf16_t* up = U + ((size_t)(2 * bp + hb_row) * 4096 + trow) * 512 + g * 16 + hq * 8;
  float x0r = 0.f, x0i = 0.f, x1r = 0.f, x1i = 0.f;
  __syncthreads();
  const bf16_t* udp = U + ((size_t)(2 * bp) * 4096 + 4 * q4) * 512 + g * 16 + c16;
  uint4 uaA = *(const uint4*)up, uaB = *(const uint4*)(up + (size_t)16 * 512);
  typedef unsigned short us2_t __attribute__((ext_vector_type(2)));
  us2_t udA[2][2], udB[2][2];
#pragma unroll
  for (int hb2 = 0; hb2 < 2; ++hb2)
#pragma unroll
    for (int i2 = 0; i2 < 2; ++i2) {
      udA[hb2][i2].x = udp[((size_t)hb2 * 4096 + 2 * i2) * 512];
      udA[hb2][i2].y = udp[((size_t)hb2 * 4096 + 2 * i2 + 1) * 512];
      udB[hb2][i2].x = udp[((size_t)hb2 * 4096 + 16 + 2 * i2) * 512];
      udB[hb2][i2].y = udp[((size_t)hb2 * 4096 + 16 + 2 * i2 + 1) * 512];
    }
  auto step = [&](int it, uint4& ua, us2_t (&ud)[2][2]) __attribute__((always_inline)) {
    const int t0 = it * 16;
    f32x16 z;
#pragma unroll
    for (int i = 0; i < 16; ++i) z[i] = 0.f;
    bf16x8 uaf = u4_to_frag(ua);
    us2_t du[2][2];
#pragma unroll
    for (int hb2 = 0; hb2 < 2; ++hb2)
#pragma unroll
      for (int i2 = 0; i2 < 2; ++i2) du[hb2][i2] = ud[hb2][i2];
    {
      const int tn = min(it + 2, 255) * 16;
      ua = *(const uint4*)(up + (size_t)tn * 512);
#pragma unroll
      for (int hb2 = 0; hb2 < 2; ++hb2)
#pragma unroll
        for (int i2 = 0; i2 < 2; ++i2) {
          ud[hb2][i2].x = udp[((size_t)hb2 * 4096 + tn + 2 * i2) * 512];
          ud[hb2][i2].y = udp[((size_t)hb2 * 4096 + tn + 2 * i2 + 1) * 512];
        }
    }
    f32x16 bu0 = mfma32(uaf, u4_to_frag(fragL[0 * 64 + lane]), z), bu1 = mfma32(uaf, u4_to_frag(fragL[1 * 64 + lane]), z);
    f32x16 bu2 = mfma32(uaf, u4_to_frag(fragL[2 * 64 + lane]), z), bu3 = mfma32(uaf, u4_to_frag(fragL[3 * 64 + lane]), z);
#pragma unroll
    for (int i = 0; i < 16; ++i) {
      float nr = a0r * x0r - a0i * x0i + bu0[i];
      float ni = a0r * x0i + a0i * x0r + bu1[i];
      x0r = nr; x0i = ni;
      nr = a1r * x1r - a1i * x1i + bu2[i];
      ni = a1r * x1i + a1i * x1r + bu3[i];
      x1r = nr; x1i = ni;
      Xl[(hq * 16 + i) * 68 + r] = pk2(x0r, x0i);
      Xl[(hq * 16 + i) * 68 + 32 + r] = pk2(x1r, x1i);
    }
    __syncthreads();
#pragma unroll
    for (int hb2 = 0; hb2 < 2; ++hb2) {
      f32x4 y = {0.f, 0.f, 0.f, 0.f};
#pragma unroll
      for (int ks = 0; ks < 4; ++ks) {
        bf16x8 a = *(const bf16x8*)&Xl[(hb2 * 16 + c16) * 68 + 16 * ks + 4 * q4];
        y = mfma16(a, u4_to_frag(fragL[(4 + ks) * 64 + lane]), y);
      }
#pragma unroll
      for (int i2 = 0; i2 < 4; ++i2) {
        size_t tok = (size_t)(2 * bp + hb2) * 4096 + t0 + 4 * q4 + i2;
        float yy = y[i2] + dcoef * bf2f((i2 & 1) ? du[hb2][i2 >> 1].y : du[hb2][i2 >> 1].x);
        Y[tok * 512 + g * 16 + c16] = f2bf(geluf_(yy));
      }
    }
    __syncthreads();
  };
  for (int it = 0; it < 256; it += 2) {
    step(it, uaA, udA);
    step(it + 1, uaB, udB);
  }
}

__device__ __forceinline__ void glu_tile(const Params& p, int l, int tile, char* smem) {
  char* ws = p.ws;
  const int m0 = (tile >> 2) * 128, n0 = (tile & 3) * 128;
  const bf16_t* Yb = (const bf16_t*)(ws + OFF_S5Y);
  const bf16_t* A = Yb + (size_t)m0 * 512;
  const bf16_t* B = (const bf16_t*)(ws + OFF_WT_GLU(l)) + (size_t)n0 * 512;
  f32x16 acc[2][2];
  zero_acc<2>(acc);
  gemm_loop<2>([=](int row, int k) __attribute__((always_inline)) { return *(const uint4*)(A + (uint32_t)(row * 512 + k)); },
            [=](int row, int k) __attribute__((always_inline)) { return *(const uint4*)(B + (uint32_t)(row * 512 + k)); }, 512, acc, smem);
  bf16_t* G = (bf16_t*)(ws + OFF_GATES);
  const float* gb = p.in[21] + l * 512;
  {
    const int lane = otid() & 63, wave = otid() >> 6;
    const int wm = wave >> 1, wn = wave & 1, r = lane & 31, h = lane >> 5;
    const float gb0 = gb[n0 + wn * 64 + r], gb1 = gb[n0 + wn * 64 + 32 + r];
#pragma unroll 1
    for (int mt = 0; mt < 2; ++mt) {
      float yv[2][16], gv[2][16];
#pragma unroll
      for (int nt = 0; nt < 2; ++nt)
#pragma unroll
        for (int i = 0; i < 16; ++i) {
          uint32_t row = m0 + wm * 64 + mt * 32 + (i & 3) + 8 * (i >> 2) + 4 * h;
          uint32_t col = n0 + wn * 64 + nt * 32 + r;
          yv[nt][i] = bf2f(Yb[row * 512u + col]);
          gv[nt][i] = bf2f(G[(size_t)row * 1536 + 512 + col]);
        }
#pragma unroll
      for (int nt = 0; nt < 2; ++nt)
#pragma unroll
        for (int i = 0; i < 16; ++i) {
          uint32_t row = m0 + wm * 64 + mt * 32 + (i & 3) + 8 * (i >> 2) + 4 * h;
          uint32_t col = n0 + wn * 64 + nt * 32 + r;
          float a_ = mt ? acc[1][nt][i] : acc[0][nt][i];
          float z = a_ + (nt ? gb1 : gb0);
          G[(size_t)row * 1536 + 512 + col] = f2bf(yv[nt][i] * sigmoidf_(z) * gv[nt][i]);
        }
    }
  }
}

struct RwPre { bf16_t R[5], K[5], V[5], W[4], A[4]; float N[4]; };
__device__ __forceinline__ void rw_prefetch(RwPre& q, const bf16_t* MX, const bf16_t* WL, const bf16_t* AAp, const float* KNp, size_t tokb, int ts0, int cr) {
#pragma unroll
  for (int i = 0; i < 5; ++i) {
    int ts = ts0 - 1 + i;
    const bf16_t* b = MX + (tokb + (ts < 0 ? 0 : ts)) * 1664;
    bf16_t r_ = b[cr], k_ = b[512 + cr], v_ = b[1024 + cr];
    q.R[i] = ts < 0 ? (bf16_t)0 : r_; q.K[i] = ts < 0 ? (bf16_t)0 : k_; q.V[i] = ts < 0 ? (bf16_t)0 : v_;
  }
#pragma unroll
  for (int i = 0; i < 4; ++i) {
    q.W[i] = WL[(tokb + ts0 + i) * 512 + cr];
    q.A[i] = AAp[(tokb + ts0 + i) * 512 + cr];
    q.N[i] = KNp[(tokb + ts0 + i) * 8];
  }
}
__device__ __forceinline__ void rwkv_rec(const Params& p, int l, int task, char* smem) {
  char* ws = p.ws;
  float* sbuf = (float*)smem;
  const int tid = otid(), lane = tid & 63, wave = tid >> 6;
  const int bh = task >> 2, qr = task & 3, b = bh >> 3, hh = bh & 7;
  const int sub = lane & 15, vrow = qr * 16 + wave * 4 + (lane >> 4);
  const int cr = hh * 64 + lane;
  const float mur = p.in[22][l * 1664 + cr], muk = p.in[22][l * 1664 + 512 + cr], muv = p.in[22][l * 1664 + 1024 + cr];
  const float kkw = p.in[27][l * 512 + cr], kaw = p.in[28][l * 512 + cr];
  const size_t tokb = (size_t)b * 4096;
  const bf16_t* MX = (const bf16_t*)(ws + OFF_MIX);
  const bf16_t* WL = (const bf16_t*)(ws + OFF_WLOG);
  const bf16_t* AAp = (const bf16_t*)(ws + OFF_AA);
  bf16_t* YR = (bf16_t*)(ws + OFF_YRAW);
  const float* KNp = (const float*)(ws + OFF_KNORM) + hh;
  float S0 = 0.f, S1 = 0.f, S2 = 0.f, S3 = 0.f;
  RwPre qa, qb;
  rw_prefetch(qa, MX, WL, AAp, KNp, tokb, wave * 4, cr);
  rw_prefetch(qb, MX, WL, AAp, KNp, tokb, 16 + wave * 4, cr);
  __syncthreads();
  auto chunk = [&](int c, RwPre& q) __attribute__((always_inline)) {
    float* dst = sbuf + (c & 1) * 6144;
#pragma unroll
    for (int i = 0; i < 4; ++i) {
      int tl = wave * 4 + i;
      float rc = bf2f(q.R[i + 1]), rp = bf2f(q.R[i]);
      float kc = bf2f(q.K[i + 1]), kp_ = bf2f(q.K[i]);
      float vc = bf2f(q.V[i + 1]), vp = bf2f(q.V[i]);
      float rv = rc + (rp - rc) * mur, kv = kc + (kp_ - kc) * muk, vv = vc + (vp - vc) * muv;
      float dec = __expf(bf2f(q.W[i]));
      float a = bf2f(q.A[i]);
      float kkn = kv * kkw * q.N[i];
      float kpr = kv * (1.f + (a - 1.f) * kaw);
      dst[0 * 1024 + tl * 64 + lane] = rv;
      dst[1 * 1024 + tl * 64 + lane] = dec;
      dst[2 * 1024 + tl * 64 + lane] = kpr;
      dst[3 * 1024 + tl * 64 + lane] = vv;
      dst[4 * 1024 + tl * 64 + lane] = -kkn;
      dst[5 * 1024 + tl * 64 + lane] = kkn * a;
    }
    __syncthreads();
    rw_prefetch(q, MX, WL, AAp, KNp, tokb, min(c + 2, 255) * 16 + wave * 4, cr);
    float ykeep = 0.f;
#pragma unroll 4
    for (int tt = 0; tt < 16; ++tt) {
      const float4 r4 = *(const float4*)&dst[0 * 1024 + tt * 64 + sub * 4];
      const float4 w4 = *(const float4*)&dst[1 * 1024 + tt * 64 + sub * 4];
      const float4 k4 = *(const float4*)&dst[2 * 1024 + tt * 64 + sub * 4];
      const float vv = dst[3 * 1024 + tt * 64 + vrow];
      const float4 a4 = *(const float4*)&dst[4 * 1024 + tt * 64 + sub * 4];
      const float4 b4 = *(const float4*)&dst[5 * 1024 + tt * 64 + sub * 4];
      float sa = (S0 * a4.x + S1 * a4.y) + (S2 * a4.z + S3 * a4.w);
      sa = rr16(sa);
      S0 = S0 * w4.x + (sa * b4.x + vv * k4.x);
      S1 = S1 * w4.y + (sa * b4.y + vv * k4.y);
      S2 = S2 * w4.z + (sa * b4.z + vv * k4.z);
      S3 = S3 * w4.w + (sa * b4.w + vv * k4.w);
      float y = (S0 * r4.x + S1 * r4.y) + (S2 * r4.z + S3 * r4.w);
      y = rr16(y);
      ykeep = (sub == tt) ? y : ykeep;
    }
    YR[(tokb + c * 16 + sub) * 512 + hh * 64 + vrow] = f2bf(ykeep);
  };
  for (int c = 0; c < 256; c += 2) {
    chunk(c, qa);
    chunk(c + 1, qb);
  }
}

__device__ __forceinline__ void rwkv_knorm(const Params& p, int l, int task) {
  char* ws = p.ws;
  const int lane = otid() & 63, wave = otid() >> 6;
  const bf16_t* MX = (const bf16_t*)(ws + OFF_MIX);
  float* KN = (float*)(ws + OFF_KNORM);
  const int c0 = lane * 8;
  float muk[8], kkw[8];
  {
    float4 a = *(const float4*)(p.in[22] + l * 1664 + 512 + c0), b = *(const float4*)(p.in[22] + l * 1664 + 512 + c0 + 4);
    muk[0] = a.x; muk[1] = a.y; muk[2] = a.z; muk[3] = a.w; muk[4] = b.x; muk[5] = b.y; muk[6] = b.z; muk[7] = b.w;
    a = *(const float4*)(p.in[27] + l * 512 + c0); b = *(const float4*)(p.in[27] + l * 512 + c0 + 4);
    kkw[0] = a.x; kkw[1] = a.y; kkw[2] = a.z; kkw[3] = a.w; kkw[4] = b.x; kkw[5] = b.y; kkw[6] = b.z; kkw[7] = b.w;
  }
  uint4 kc4[8], kp4[8];
#pragma unroll
  for (int it = 0; it < 8; ++it) {
    const int tok = task * 32 + wave * 8 + it;
    const bool first = (tok & 4095) == 0;
    kc4[it] = *(const uint4*)(MX + (size_t)tok * 1664 + 512 + c0);
    kp4[it] = *(const uint4*)(MX + (size_t)(first ? tok : tok - 1) * 1664 + 512 + c0);
  }
#pragma unroll
  for (int it = 0; it < 8; ++it) {
    const int tok = task * 32 + wave * 8 + it;
    const bool first = (tok & 4095) == 0;
    float kc[8], kp[8];
    kc[0] = lo_bf(kc4[it].x); kc[1] = hi_bf(kc4[it].x); kc[2] = lo_bf(kc4[it].y); kc[3] = hi_bf(kc4[it].y);
    kc[4] = lo_bf(kc4[it].z); kc[5] = hi_bf(kc4[it].z); kc[6] = lo_bf(kc4[it].w); kc[7] = hi_bf(kc4[it].w);
    kp[0] = lo_bf(kp4[it].x); kp[1] = hi_bf(kp4[it].x); kp[2] = lo_bf(kp4[it].y); kp[3] = hi_bf(kp4[it].y);
    kp[4] = lo_bf(kp4[it].z); kp[5] = hi_bf(kp4[it].z); kp[6] = lo_bf(kp4[it].w); kp[7] = hi_bf(kp4[it].w);
    float ss = 0.f;
#pragma unroll
    for (int i = 0; i < 8; ++i) {
      float pk = first ? 0.f : kp[i];
      float kq = (kc[i] + (pk - kc[i]) * muk[i]) * kkw[i];
      ss += kq * kq;
    }
    ss = rr8(ss);
    if ((lane & 7) == 0) KN[(size_t)tok * 8 + (lane >> 3)] = 1.f / fmaxf(sqrtf(ss), 1e-12f);
  }
}

__device__ __forceinline__ void unpack8(uint4 v, float (&f)[8]) {
  f[0] = lo_bf(v.x); f[1] = hi_bf(v.x); f[2] = lo_bf(v.y); f[3] = hi_bf(v.y);
  f[4] = lo_bf(v.z); f[5] = hi_bf(v.z); f[6] = lo_bf(v.w); f[7] = hi_bf(v.w);
}
__device__ __forceinline__ void load8f(const float* p, float (&f)[8]) {
  float4 a = *(const float4*)p, b = *(const float4*)(p + 4);
  f[0] = a.x; f[1] = a.y; f[2] = a.z; f[3] = a.w; f[4] = b.x; f[5] = b.y; f[6] = b.z; f[7] = b.w;
}
__device__ __forceinline__ void rwkv_post(const Params& p, int l, int task) {
  char* ws = p.ws;
  const int lane = otid() & 63, wave = otid() >> 6;
  const bf16_t* MX = (const bf16_t*)(ws + OFF_MIX);
  const bf16_t* AAp = (const bf16_t*)(ws + OFF_AA);
  const bf16_t* YR = (const bf16_t*)(ws + OFF_YRAW);
  bf16_t* G = (bf16_t*)(ws + OFF_GATES);
  const int c0 = lane * 8;
  float lnw[8], lnb[8], mur[8], muk[8], muv[8], ka[8], rk[8];
  load8f(p.in[30] + l * 512 + c0, lnw);
  load8f(p.in[31] + l * 512 + c0, lnb);
  load8f(p.in[22] + l * 1664 + c0, mur);
  load8f(p.in[22] + l * 1664 + 512 + c0, muk);
  load8f(p.in[22] + l * 1664 + 1024 + c0, muv);
  load8f(p.in[28] + l * 512 + c0, ka);
  load8f(p.in[29] + l * 512 + c0, rk);
#pragma unroll 1
  for (int it = 0; it < 8; it += 2) {
    uint4 y4[2], rc4[2], kc4[2], vc4[2], rp4[2], kp4[2], vp4[2], a4[2], g4[2];
#pragma unroll
    for (int u = 0; u < 2; ++u) {
      const int tok = task * 32 + wave * 8 + it + u;
      const bool first = (tok & 4095) == 0;
      const bf16_t* cur = MX + (size_t)tok * 1664 + c0;
      const bf16_t* prv = MX + (size_t)(first ? tok : tok - 1) * 1664 + c0;
      y4[u] = *(const uint4*)(YR + (size_t)tok * 512 + c0);
      rc4[u] = *(const uint4*)(cur); kc4[u] = *(const uint4*)(cur + 512); vc4[u] = *(const uint4*)(cur + 1024);
      rp4[u] = *(const uint4*)(prv); kp4[u] = *(const uint4*)(prv + 512); vp4[u] = *(const uint4*)(prv + 1024);
      a4[u] = *(const uint4*)(AAp + (size_t)tok * 512 + c0);
      g4[u] = *(const uint4*)(G + (size_t)tok * 1536 + 1024 + c0);
    }
#pragma unroll
    for (int u = 0; u < 2; ++u) {
      const int tok = task * 32 + wave * 8 + it + u;
      const bool first = (tok & 4095) == 0;
      float y[8], rc[8], kc[8], vc[8], rp[8], kp[8], vp[8], a[8], g[8];
      unpack8(y4[u], y); unpack8(rc4[u], rc); unpack8(kc4[u], kc); unpack8(vc4[u], vc);
      unpack8(rp4[u], rp); unpack8(kp4[u], kp); unpack8(vp4[u], vp); unpack8(a4[u], a); unpack8(g4[u], g);
      float sm = 0.f;
#pragma unroll
      for (int i = 0; i < 8; ++i) sm += y[i];
      const float mean = rr8(sm) * (1.f / 64.f);
      float sq = 0.f;
#pragma unroll
      for (int i = 0; i < 8; ++i) { y[i] -= mean; sq += y[i] * y[i]; }
      const float rs = rsqrtf(rr8(sq) * (1.f / 64.f) + 64e-5f);
      float bs = 0.f, vv[8];
#pragma unroll
      for (int i = 0; i < 8; ++i) {
        float pr = first ? 0.f : rp[i], pk = first ? 0.f : kp[i], pv = first ? 0.f : vp[i];
        float rv = rc[i] + (pr - rc[i]) * mur[i];
        float kv = kc[i] + (pk - kc[i]) * muk[i];
        vv[i] = vc[i] + (pv - vc[i]) * muv[i];
        float kpr = kv * (1.f + (a[i] - 1.f) * ka[i]);
        bs += rv * kpr * rk[i];
      }
      bs = rr8(bs);
      float o[8];
#pragma unroll
      for (int i = 0; i < 8; ++i) o[i] = (y[i] * rs * lnw[i] + lnb[i] + bs * vv[i]) * g[i];
      uint4 ov; ov.x = pk2(o[0], o[1]); ov.y = pk2(o[2], o[3]); ov.z = pk2(o[4], o[5]); ov.w = pk2(o[6], o[7]);
      *(uint4*)(G + (size_t)tok * 1536 + 1024 + c0) = ov;
    }
  }
}

template <int MODE, bool EDGE>
__device__ __forceinline__ void nsa_half(int kt, int half, const bf16x8 (&qf)[4], int t, bool bsel, float& m, float& lsum,
                                         f32x16& o0, f32x16& o1, const bf16_t* Ks, const bf16_t* Vt, int r, int h) {
  f32x16 s;
#pragma unroll
  for (int i = 0; i < 16; ++i) s[i] = 0.f;
#pragma unroll
  for (int sp = 0; sp < 4; ++sp) {
    bf16x8 a = *(const bf16x8*)&Ks[(half * 32 + r) * 72 + sp * 16 + h * 8];
    s = mfma32(a, qf[sp], s);
  }
  if (EDGE) {
#pragma unroll
    for (int i = 0; i < 16; ++i) {
      int key = kt * 64 + half * 32 + (i & 3) + 8 * (i >> 2) + 4 * h;
      bool v = (key <= t) && (MODE == 0 || key > t - 512);
      s[i] = v ? s[i] : -1e30f;
    }
  }
  float tmax = s[0];
#pragma unroll
  for (int i = 1; i < 16; ++i) tmax = fmaxf(tmax, s[i]);
  tmax = bsel ? tmax : -1e30f;
  tmax = fmaxf(tmax, __shfl_xor(tmax, 32));
  const float mn = fmaxf(m, tmax);
  const bool same = (mn == m);
  const float alpha = ex2(m - mn);
  m = mn;
  const float mb = bsel ? mn : 3e38f;
  float pv[16], ps = 0.f;
#pragma unroll
  for (int i = 0; i < 16; ++i) {
    float e = ex2(s[i] - mb);
    if (EDGE) e = (s[i] > -1e29f) ? e : 0.f;
    pv[i] = e;
    ps += e;
  }
  lsum = lsum * alpha + ps;
  if (!__all(same)) {
#pragma unroll
    for (int i = 0; i < 16; ++i) { o0[i] *= alpha; o1[i] *= alpha; }
  }
  bf16x8 pf0 = pack_frag(pv[0], pv[1], pv[2], pv[3], pv[4], pv[5], pv[6], pv[7]);
  bf16x8 pf1 = pack_frag(pv[8], pv[9], pv[10], pv[11], pv[12], pv[13], pv[14], pv[15]);
#pragma unroll
  for (int sidx = 0; sidx < 2; ++sidx) {
    uint2 l0 = *(const uint2*)&Vt[r * 72 + half * 32 + sidx * 16 + 4 * h];
    uint2 l1 = *(const uint2*)&Vt[r * 72 + half * 32 + sidx * 16 + 8 + 4 * h];
    uint2 l2 = *(const uint2*)&Vt[(32 + r) * 72 + half * 32 + sidx * 16 + 4 * h];
    uint2 l3 = *(const uint2*)&Vt[(32 + r) * 72 + half * 32 + sidx * 16 + 8 + 4 * h];
    bf16x8 va0 = u4_to_frag(make_uint4(l0.x, l0.y, l1.x, l1.y));
    bf16x8 va1 = u4_to_frag(make_uint4(l2.x, l2.y, l3.x, l3.y));
    o0 = mfma32(va0, sidx ? pf1 : pf0, o0);
    o1 = mfma32(va1, sidx ? pf1 : pf0, o1);
  }
}

template <int MODE>
__device__ __forceinline__ void nsa_sweep(const bf16_t* Kb, const bf16_t* Vtb, int tile_lo, int tile_hi, const bf16x8 (&qf)[4],
                                          int t, int t0, unsigned long long selmask, f32x16& o0, f32x16& o1, float& lout, bf16_t* Ks0) {
  const int tid = otid(), lane = tid & 63, r = lane & 31, h = lane >> 5;
  float m = -1e30f, lsum = 0.f;
#pragma unroll
  for (int i = 0; i < 16; ++i) { o0[i] = 0.f; o1[i] = 0.f; }
  const int row0_ = tid >> 3, kc0_ = tid & 7, row1_ = (tid + 256) >> 3;
  uint4 pk0, pk1, pv0, pv1;
#define KVLOAD(KT) { const int kt__ = (KT); \
    pk0 = *(const uint4*)(Kb + (size_t)(kt__ * 64 + row0_) * 64 + kc0_ * 8); \
    pk1 = *(const uint4*)(Kb + (size_t)(kt__ * 64 + row1_) * 64 + kc0_ * 8); \
    pv0 = *(const uint4*)(Vtb + (size_t)row0_ * 4096 + kt__ * 64 + kc0_ * 8); \
    pv1 = *(const uint4*)(Vtb + (size_t)row1_ * 4096 + kt__ * 64 + kc0_ * 8); }
#define KVWRITE(BUF) { bf16_t* d__ = Ks0 + (BUF) * (128 * 72); \
    *(uint4*)&d__[row0_ * 72 + kc0_ * 8] = pk0; \
    *(uint4*)&d__[row1_ * 72 + kc0_ * 8] = pk1; \
    *(uint4*)&d__[64 * 72 + row0_ * 72 + kc0_ * 8] = pv0; \
    *(uint4*)&d__[64 * 72 + row1_ * 72 + kc0_ * 8] = pv1; }
  KVLOAD(tile_lo);
  __syncthreads();
  KVWRITE(0);
  __syncthreads();
  for (int kt = tile_lo; kt <= tile_hi; ++kt) {
    const int cur = (kt - tile_lo) & 1;
    const bf16_t* Ks = Ks0 + cur * (128 * 72);
    const bf16_t* Vt = Ks + 64 * 72;
    KVLOAD(min(kt + 1, tile_hi));
    const bool bsel = (MODE == 0) ? (((selmask >> kt) & 1ull) != 0) : true;
    const bool interior = (kt * 64 + 63 <= t0) && (MODE == 0 || kt * 64 > t0 + 31 - 512);
    if (interior) {
#pragma unroll 1
      for (int half = 0; half < 2; ++half) nsa_half<MODE, false>(kt, half, qf, t, bsel, m, lsum, o0, o1, Ks, Vt, r, h);
    } else {
#pragma unroll 1
      for (int half = 0; half < 2; ++half) nsa_half<MODE, true>(kt, half, qf, t, bsel, m, lsum, o0, o1, Ks, Vt, r, h);
    }
    KVWRITE(cur ^ 1);
    __syncthreads();
  }
  lout = lsum + __shfl_xor(lsum, 32);
}

__device__ __forceinline__ void nsa_tile(const Params& p, int l, int task, char* smem) {
  char* ws = p.ws;
  bf16_t* Ks = (bf16_t*)smem;
  bf16_t* Vt = Ks + 64 * 72;
  float* impL = (float*)(smem + 4 * 64 * 72 * 2);
  float* impS = impL + 4 * 32 * 65;
  unsigned char* selB = (unsigned char*)(impS + 32 * 65);
  const int tid = otid(), lane = tid & 63, wave = tid >> 6, r = lane & 31, h = lane >> 5;
  const int bg = task & 15, tt = 127 - (task >> 4);
  const int b = bg >> 1, g = bg & 1;
  const int t0 = tt * 32, t = t0 + r, blk_t = t0 >> 6;
  const int head = g * 4 + wave;
  const size_t tok = (size_t)b * 4096 + t;
  bf16x8 qf[4];
  {
    const bf16_t* Qp = (const bf16_t*)(ws + OFF_Q) + tok * 512 + head * 64 + h * 8;
#pragma unroll
    for (int sp = 0; sp < 4; ++sp) qf[sp] = *(const bf16x8*)(Qp + sp * 16);
  }
  const float* ng = (const float*)(ws + OFF_NSAG) + tok * 32 + head * 3;
  const float g0 = sigmoidf_(ng[0]), g1 = sigmoidf_(ng[1]), g2 = sigmoidf_(ng[2]);
  f32x16 oc0, oc1;
  float* outL = impL;
  const bf16_t* KCb = (const bf16_t*)(ws + OFF_KCMP) + (size_t)bg * 256 * 64;
  const bf16_t* VCb = (const bf16_t*)(ws + OFF_VCMPT) + (size_t)bg * 64 * 256;
  const int nct = (t0 >> 9) + 1;
  float m = -1e30f, lsum = 0.f;
  for (int ct = 0; ct < nct; ++ct) {
    __syncthreads();
    { int row = tid >> 3, kc = tid & 7; *(uint4*)&Ks[row * 72 + kc * 8] = *(const uint4*)(KCb + (size_t)(ct * 32 + row) * 64 + kc * 8); }
    __syncthreads();
    f32x16 s;
#pragma unroll
    for (int i = 0; i < 16; ++i) s[i] = 0.f;
#pragma unroll
    for (int sp = 0; sp < 4; ++sp) {
      bf16x8 a = *(const bf16x8*)&Ks[r * 72 + sp * 16 + h * 8];
      s = mfma32(a, qf[sp], s);
    }
    float tmax = -1e30f;
#pragma unroll
    for (int i = 0; i < 16; ++i) {
      int n = ct * 32 + (i & 3) + 8 * (i >> 2) + 4 * h;
      bool v = (16 * n + 31 <= t);
      tmax = fmaxf(tmax, v ? s[i] : -1e30f);
    }
    float mn = fmaxf(m, tmax), ps = 0.f;
#pragma unroll
    for (int i = 0; i < 16; ++i) {
      int n = ct * 32 + (i & 3) + 8 * (i >> 2) + 4 * h;
      bool v = (16 * n + 31 <= t);
      ps += v ? ex2(s[i] - mn) : 0.f;
    }
    lsum = lsum * ex2(m - mn) + ps;
    m = mn;
  }
  {
    float mo = __shfl_xor(m, 32), lo = __shfl_xor(lsum, 32);
    float mt_ = fmaxf(m, mo);
    float lt = lsum * ex2(m - mt_) + lo * ex2(mo - mt_);
    m = mt_;
    lsum = lt > 0.f ? 1.f / lt : 0.f;
  }
  {
#pragma unroll
    for (int i = 0; i < 16; ++i) { oc0[i] = 0.f; oc1[i] = 0.f; }
    float carry = 0.f;
    for (int ct = 0; ct < nct; ++ct) {
      __syncthreads();
      { int row = tid >> 3, kc = tid & 7; *(uint4*)&Ks[row * 72 + kc * 8] = *(const uint4*)(KCb + (size_t)(ct * 32 + row) * 64 + kc * 8); }
      { int row = tid >> 2, kc = tid & 3; *(uint4*)&Vt[row * 72 + kc * 8] = *(const uint4*)(VCb + (size_t)row * 256 + ct * 32 + kc * 8); }
      __syncthreads();
      f32x16 s;
#pragma unroll
      for (int i = 0; i < 16; ++i) s[i] = 0.f;
#pragma unroll
      for (int sp = 0; sp < 4; ++sp) {
        bf16x8 a = *(const bf16x8*)&Ks[r * 72 + sp * 16 + h * 8];
        s = mfma32(a, qf[sp], s);
      }
      float pv[16];
#pragma unroll
      for (int i = 0; i < 16; ++i) {
        int n = ct * 32 + (i & 3) + 8 * (i >> 2) + 4 * h;
        bool v = (16 * n + 31 <= t);
        pv[i] = v ? ex2(s[i] - m) * lsum : 0.f;
      }
      bf16x8 pf0 = pack_frag(pv[0], pv[1], pv[2], pv[3], pv[4], pv[5], pv[6], pv[7]);
      bf16x8 pf1 = pack_frag(pv[8], pv[9], pv[10], pv[11], pv[12], pv[13], pv[14], pv[15]);
#pragma unroll
      for (int sidx = 0; sidx < 2; ++sidx) {
        uint2 l0 = *(const uint2*)&Vt[r * 72 + sidx * 16 + 4 * h];
        uint2 l1 = *(const uint2*)&Vt[r * 72 + sidx * 16 + 8 + 4 * h];
        uint2 l2 = *(const uint2*)&Vt[(32 + r) * 72 + sidx * 16 + 4 * h];
        uint2 l3 = *(const uint2*)&Vt[(32 + r) * 72 + sidx * 16 + 8 + 4 * h];
        bf16x8 va0 = u4_to_frag(make_uint4(l0.x, l0.y, l1.x, l1.y));
        bf16x8 va1 = u4_to_frag(make_uint4(l2.x, l2.y, l3.x, l3.y));
        oc0 = mfma32(va0, sidx ? pf1 : pf0, oc0);
        oc1 = mfma32(va1, sidx ? pf1 : pf0, oc1);
      }
#pragma unroll
      for (int qd = 0; qd < 4; ++qd) {
        float A_ = pv[4 * qd] + pv[4 * qd + 1] + pv[4 * qd + 2] + 0.5f * pv[4 * qd + 3];
        float B_ = 0.5f * pv[4 * qd + 3];
        float recv = __shfl_xor(B_, 32);
        float val = A_ + (h ? recv : carry);
        carry = recv;
        impL[(wave * 32 + r) * 65 + 8 * ct + 2 * qd + h] = val;
      }
    }
  }
  __syncthreads();
  {
    const int tk = tid >> 3, mg = tid & 7;
#pragma unroll
    for (int j = 0; j < 8; ++j) {
      int m_ = mg * 8 + j;
      float v = 0.f;
      if (m_ <= blk_t) v = (impL[(0 * 32 + tk) * 65 + m_] + impL[(1 * 32 + tk) * 65 + m_]) + (impL[(2 * 32 + tk) * 65 + m_] + impL[(3 * 32 + tk) * 65 + m_]);
      impS[tk * 65 + m_] = v;
    }
    __syncthreads();
    unsigned bits = 0;
#pragma unroll
    for (int j = 0; j < 8; ++j) {
      int m_ = mg * 8 + j;
      bool sel;
      if (m_ > blk_t) sel = false;
      else if (m_ == 0 || m_ == blk_t || blk_t < 16) sel = true;
      else {
        float v = impS[tk * 65 + m_];
        int cnt = 0;
        for (int m2 = 1; m2 < blk_t; ++m2) {
          float v2 = impS[tk * 65 + m2];
          cnt += ((v2 > v) || (v2 == v && m2 < m_)) ? 1 : 0;
        }
        sel = cnt < 14;
      }
      bits |= (sel ? 1u : 0u) << j;
    }
    selB[tk * 8 + mg] = (unsigned char)bits;
  }
  __syncthreads();
  const unsigned long long selmask = *(const unsigned long long*)&selB[r * 8];
#pragma unroll
  for (int i = 0; i < 16; ++i) { outL[i * 256 + tid] = g0 * oc0[i]; outL[(16 + i) * 256 + tid] = g0 * oc1[i]; }
  {
    f32x16 o0, o1; float ls;
    nsa_sweep<0>((const bf16_t*)(ws + OFF_KS) + (size_t)bg * 4096 * 64, (const bf16_t*)(ws + OFF_VST) + (size_t)bg * 64 * 4096,
                 0, blk_t, qf, t, t0, selmask, o0, o1, ls, Ks);
    float sc = g1 / ls;
#pragma unroll
    for (int i = 0; i < 16; ++i) { outL[i * 256 + tid] += sc * o0[i]; outL[(16 + i) * 256 + tid] += sc * o1[i]; }
  }
  {
    f32x16 o0, o1; float ls;
    int lo = t0 - 511; lo = lo < 0 ? 0 : lo;
    nsa_sweep<1>((const bf16_t*)(ws + OFF_KW) + (size_t)bg * 4096 * 64, (const bf16_t*)(ws + OFF_VWT) + (size_t)bg * 64 * 4096,
                 lo >> 6, blk_t, qf, t, t0, 0ull, o0, o1, ls, Ks);
    float sc = g2 / ls;
#pragma unroll
    for (int i = 0; i < 16; ++i) { oc0[i] = outL[i * 256 + tid] + sc * o0[i]; oc1[i] = outL[(16 + i) * 256 + tid] + sc * o1[i]; }
  }
  bf16_t* G = (bf16_t*)(ws + OFF_GATES) + tok * 1536 + head * 64;
  uint2 gva[4], gvb[4];
#pragma unroll
  for (int qd = 0; qd < 4; ++qd) {
    gva[qd] = *(const uint2*)(G + 8 * qd + 4 * h);
    gvb[qd] = *(const uint2*)(G + 32 + 8 * qd + 4 * h);
  }
#pragma unroll
  for (int qd = 0; qd < 4; ++qd) {
    int d0 = 8 * qd + 4 * h;
    uint2 ov;
    ov.x = pk2(oc0[4 * qd] * lo_bf(gva[qd].x), oc0[4 * qd + 1] * hi_bf(gva[qd].x));
    ov.y = pk2(oc0[4 * qd + 2] * lo_bf(gva[qd].y), oc0[4 * qd + 3] * hi_bf(gva[qd].y));
    *(uint2*)(G + d0) = ov;
    ov.x = pk2(oc1[4 * qd] * lo_bf(gvb[qd].x), oc1[4 * qd + 1] * hi_bf(gvb[qd].x));
    ov.y = pk2(oc1[4 * qd + 2] * lo_bf(gvb[qd].y), oc1[4 * qd + 3] * hi_bf(gvb[qd].y));
    *(uint2*)(G + 32 + d0) = ov;
  }
}

__device__ __forceinline__ void merge_tile(const Params& p, int l, int tile, char* smem) {
  char* ws = p.ws;
  const int m0 = (tile >> 3) * 128, n0 = (tile & 7) * 128;
  const bf16_t* Hh = (const bf16_t*)(ws + OFF_H2) + (size_t)m0 * 1024;
  const bf16_t* Br = (const bf16_t*)(ws + OFF_GATES) + (size_t)m0 * 1536;
  uint32_t* sgL = (uint32_t*)(smem + 36864) + otid();
  f32x16 mg[2][2];
  zero_acc<2>(mg);
#pragma unroll 1
  for (int n = 0; n < 3; ++n) {
    f32x16 acc[2][2];
    zero_acc<2>(acc);
    const bf16_t* Bg = (const bf16_t*)(ws + OFF_WT_IN(l)) + (size_t)(5120 + n * 1024 + n0) * 1024;
    gemm_loop<2, true>([=](int row, int k) __attribute__((always_inline)) { return *(const uint4*)(Hh + (uint32_t)(row * 1024 + k)); },
                       [=](int row, int k) __attribute__((always_inline)) { return *(const uint4*)(Bg + (uint32_t)(row * 1024 + k)); }, 1024, acc, smem);
#pragma unroll
    for (int a = 0; a < 2; ++a)
#pragma unroll
      for (int b = 0; b < 2; ++b)
#pragma unroll
        for (int i = 0; i < 8; ++i) sgL[((a * 2 + b) * 8 + i) * 256] = pk2(sigmoidf_(acc[a][b][2 * i]), sigmoidf_(acc[a][b][2 * i + 1]));
    zero_acc<2>(acc);
    const bf16_t* Bu = (const bf16_t*)(ws + OFF_WT_UP(l)) + ((size_t)n * 1024 + n0) * 512;
    const bf16_t* Ab = Br + n * 512;
    gemm_loop<2, true>([=](int row, int k) __attribute__((always_inline)) { return *(const uint4*)(Ab + (uint32_t)(row * 1536 + k)); },
                       [=](int row, int k) __attribute__((always_inline)) { return *(const uint4*)(Bu + (uint32_t)(row * 512 + k)); }, 512, acc, smem);
#pragma unroll
    for (int a = 0; a < 2; ++a)
#pragma unroll
      for (int b = 0; b < 2; ++b)
#pragma unroll
        for (int i = 0; i < 8; ++i) {
          uint32_t sv = sgL[((a * 2 + b) * 8 + i) * 256];
          mg[a][b][2 * i] += lo_bf(sv) * acc[a][b][2 * i];
          mg[a][b][2 * i + 1] += hi_bf(sv) * acc[a][b][2 * i + 1];
        }
  }
  bf16_t* M = (bf16_t*)(ws + OFF_MERGED);
  gemm_epi(mg, m0, n0, [=](int row0, int col, float a0, float a1, float a2, float a3, float b0, float b1, float b2, float b3) __attribute__((always_inline)) {
    float av[4] = {a0, a1, a2, a3}, bv[4] = {b0, b1, b2, b3};
#pragma unroll
    for (int j = 0; j < 4; ++j) {
      M[(size_t)(row0 + j) * 1024 + col] = f2bf(av[j]);
      M[(size_t)(row0 + j) * 1024 + col + 32] = f2bf(bv[j]);
    }
  });
}

__device__ __forceinline__ void out_tile(const Params& p, int l, int tile, char* smem) {
  char* ws = p.ws;
  const int m0 = (tile >> 3) * 128, n0 = (tile & 7) * 128;
  const bf16_t* A = (const bf16_t*)(ws + OFF_MERGED) + (size_t)m0 * 1024;
  const bf16_t* B = (const bf16_t*)(ws + OFF_WT_OUT(l)) + (size_t)n0 * 1024;
  f32x16 acc[2][2];
  zero_acc<2>(acc);
  gemm_loop<2>([=](int row, int k) __attribute__((always_inline)) { return *(const uint4*)(A + (uint32_t)(row * 1024 + k)); },
            [=](int row, int k) __attribute__((always_inline)) { return *(const uint4*)(B + (uint32_t)(row * 1024 + k)); }, 1024, acc, smem);
  const float* xin = (l == 0) ? p.in[0] : p.out;
  float* xo = p.out;
  const float* md = (const float*)(ws + OFF_MOD) + (size_t)l * 8 * 3072 + 2048;
  {
    const int lane = otid() & 63, wave = otid() >> 6;
    const int wm = wave >> 1, wn = wave & 1, r = lane & 31, h = lane >> 5;
    const int b = m0 >> 12;
    const float g0 = md[b * 3072 + n0 + wn * 64 + r], g1 = md[b * 3072 + n0 + wn * 64 + 32 + r];
    float xv[2][2][16];
#pragma unroll
    for (int mt = 0; mt < 2; ++mt)
#pragma unroll
      for (int nt = 0; nt < 2; ++nt)
#pragma unroll
        for (int i = 0; i < 16; ++i) {
          int row = m0 + wm * 64 + mt * 32 + (i & 3) + 8 * (i >> 2) + 4 * h;
          xv[mt][nt][i] = xin[(size_t)row * 1024 + n0 + wn * 64 + nt * 32 + r];
        }
#pragma unroll
    for (int mt = 0; mt < 2; ++mt)
#pragma unroll
      for (int nt = 0; nt < 2; ++nt)
#pragma unroll
        for (int i = 0; i < 16; ++i) {
          int row = m0 + wm * 64 + mt * 32 + (i & 3) + 8 * (i >> 2) + 4 * h;
          xo[(size_t)row * 1024 + n0 + wn * 64 + nt * 32 + r] = xv[mt][nt][i] + (nt ? g1 : g0) * acc[mt][nt][i];
        }
  }
}

#define N_PHASES 18
#define OFF_CTR (499 * MIB)
__device__ __forceinline__ int next_tile(int* ctr, char* smem) {
  int* st = (int*)(smem + SMEM_BYTES - 16);
  __syncthreads();
  if (otid() == 0) *st = atomicAdd(ctr, 1);
  __syncthreads();
  return __builtin_amdgcn_readfirstlane(*st);
}
__device__ __forceinline__ unsigned xcc_id() { return (unsigned)__builtin_amdgcn_s_getreg((3 << 11) | 20) & 7u; }
__device__ __forceinline__ int next_tile_x(int* ctrs, int per_xcd, int xcd0, int& xq, char* smem) {
  int* st = (int*)(smem + SMEM_BYTES - 16);
  __syncthreads();
  if (otid() == 0) {
    int res = -1, q = xq;
    while (q < 8) {
      int x = (xcd0 + q) & 7;
      int i = atomicAdd(&ctrs[x], 1);
      if (i < per_xcd) { res = x * per_xcd + i; break; }
      ++q;
    }
    st[0] = res; st[1] = q;
  }
  __syncthreads();
  xq = __builtin_amdgcn_readfirstlane(st[1]);
  return __builtin_amdgcn_readfirstlane(st[0]);
}
__device__ __forceinline__ void run_phase(const Params& p, int ph, char* smem, int mask = 7) {
  const int vb = blockIdx.x, nvb = gridDim.x, wave = otid() >> 6;
  int* ctr = (int*)(p.ws + OFF_CTR) + ph;
  int* ctrx = (int*)(p.ws + OFF_CTR) + 32 + ph * 8;
  const int xcd0 = (int)xcc_id();
  int xq = 0;
  if (ph == 0) {
    for (int i = vb * 256 + otid(); i < 5120; i += nvb * 256) ((int*)(p.ws + OFF_CTR))[i] = 0;
    phase_prep(p, smem);
    return;
  }
  if (ph == 17) {
    for (int row = (vb * 4 + wave) * 4; row < NTOK; row += nvb * 16) final_norm_rows<4>(p, row);
    return;
  }
  const int l = (ph - 1) >> 3, sp = (ph - 1) & 7;
  switch (sp) {
    case 0:
      for (int row = (vb * 4 + wave) * 4; row < NTOK; row += nvb * 16) norm_rows<4>(p, l, row, (bf16_t*)(p.ws + OFF_H1));
      break;
    case 1:
      for (int t = next_tile_x(ctrx, 640, xcd0, xq, smem); t >= 0; t = next_tile_x(ctrx, 640, xcd0, xq, smem)) {
        int x = t / 640, i = t % 640;
        proj_tile(p, l, ((x >> 2) * 64 + i / 10) * 40 + (x & 3) * 10 + (i % 10), smem);
      }
      break;
    case 2:
      for (int t = next_tile(ctr, smem); t < 128 + 2048 + 1024; t = next_tile(ctr, smem)) {
        if (t < 128) cmp1_tile(p, l, t, smem);
        else if (t < 128 + 2048) lora_tile(p, l, t - 128, smem);
        else rwkv_knorm(p, l, t - 128 - 2048);
      }
      break;
    case 3:
      for (int t = next_tile(ctr, smem); t < 64; t = next_tile(ctr, smem)) cmp2_tile(p, l, t, smem);
      break;
    case 4:
    {
      int* st = (int*)(smem + SMEM_BYTES - 16);
      __syncthreads();
      if (otid() == 0) {
        unsigned key = (unsigned)xcd0 * 256u + (((unsigned)__builtin_amdgcn_s_getreg(63492) >> 8) & 0xffu);
        st[2] = atomicAdd((int*)(p.ws + OFF_CTR) + 1024 + l * 2048 + key, 1);
      }
      __syncthreads();
      const bool longrole = (st[2] == 0);
      int* ctr_s5 = (int*)(p.ws + OFF_CTR) + 200 + ph;
      for (int stage = 0; stage < 3; ++stage) {
        const int which = longrole ? stage : (stage + 1) % 3;
        if (which == 0) {
          if (mask & 1)
            for (int t = next_tile(ctr, smem); t < 256; t = next_tile(ctr, smem)) rwkv_rec(p, l, t, smem);
        } else if (which == 1) {
          if (mask & 2)
            for (int t = next_tile(ctr_s5, smem); t < 32; t = next_tile(ctr_s5, smem)) s5_scan(p, l, t, smem);
        } else {
          if (mask & 4)
            for (int t = next_tile_x(ctrx, 256, xcd0, xq, smem); t >= 0; t = next_tile_x(ctrx, 256, xcd0, xq, smem)) {
              int x = t >> 8, i = t & 255;
              nsa_tile(p, l, ((i >> 1) << 4) | (2 * x + (i & 1)), smem);
            }
        }
      }
      break;
    }
    case 5:
      for (int t = next_tile(ctr, smem); t < 1024 + 1024 + 1024; t = next_tile(ctr, smem)) {
        if (t < 1024) glu_tile(p, l, t, smem);
        else if (t < 2048) rwkv_post(p, l, t - 1024);
        else {
          int base = (t - 2048) * 32 + wave * 8;
          for (int i = 0; i < 8; i += 4) norm_rows<4>(p, l, base + i, (bf16_t*)(p.ws + OFF_H2));
        }
      }
      break;
    case 6:
      for (int t = next_tile_x(ctrx, 256, xcd0, xq, smem); t >= 0; t = next_tile_x(ctrx, 256, xcd0, xq, smem)) {
        int x = t >> 8, i = t & 255;
        merge_tile(p, l, ((x >> 2) * 128 + (i >> 1)) * 8 + (x & 3) * 2 + (i & 1), smem);
      }
      break;
    case 7:
      for (int t = next_tile_x(ctrx, 256, xcd0, xq, smem); t >= 0; t = next_tile_x(ctrx, 256, xcd0, xq, smem)) {
        int x = t >> 8, i = t & 255;
        out_tile(p, l, (32 * x + (i >> 3)) * 8 + (i & 7), smem);
      }
      break;
  }
}


#define XB_TMO      128
#define XB_XCNT(j)  (256  + 64 * (j))
#define XB_XSUB(j)  (1280 + 64 * (j))
#define XB_XGEN(j)  (2304 + 64 * (j))
#define XB_TOP      3328
#define XB_TOPGEN   3392
#define XCD_BAR_WORDS 3456
#define XB_SPIN_CAP (1u << 22)
#define LAS __attribute__((address_space(3)))
__device__ __forceinline__ unsigned xb_ld(unsigned* p)              { return __hip_atomic_load(p, __ATOMIC_RELAXED, __HIP_MEMORY_SCOPE_AGENT); }
__device__ __forceinline__ unsigned xb_add(unsigned* p, unsigned v) { return __hip_atomic_fetch_add(p, v, __ATOMIC_RELAXED, __HIP_MEMORY_SCOPE_AGENT); }
__device__ __forceinline__ unsigned xb_xcc_id() { return (unsigned)__builtin_amdgcn_s_getreg((3 << 11) | 20) & 0xFu; }
#define XB_SPIN(cond, bar) do { unsigned _sp = 0; while (cond) { __builtin_amdgcn_s_sleep(1); \
    if ((++_sp & 255u) == 0u) { if (xb_ld(&(bar)[XB_TMO])) break; if (_sp > XB_SPIN_CAP) { atomicAdd(&(bar)[XB_TMO], 1u); break; } } } } while (0)
struct XcdBarrier { unsigned* bar; unsigned x; volatile LAS unsigned* st; };
__device__ __forceinline__ XcdBarrier xcd_barrier_post(unsigned* bar, volatile LAS unsigned* st) {
  XcdBarrier b; b.bar = bar; b.x = xb_xcc_id(); b.st = st;
  if (threadIdx.x == 0) (void)xb_add(&bar[XB_XCNT(b.x)], 1u);
  return b;
}
__device__ __forceinline__ void xcd_barrier_complete(unsigned* bar, unsigned x, unsigned& nloc, unsigned& nx) {
  const unsigned G = gridDim.x * gridDim.y * gridDim.z;
  unsigned sum, cnt, mine, sp = 0u;
  for (;;) {
    sum = 0u; cnt = 0u; mine = 0u;
#pragma unroll
    for (unsigned j = 0; j < 16; ++j) { const unsigned c = xb_ld(&bar[XB_XCNT(j)]); sum += c; cnt += (c > 0u) ? 1u : 0u; mine = (j == x) ? c : mine; }
    if (sum == G) break;
    __builtin_amdgcn_s_sleep(1);
    if ((++sp & 255u) == 0u) { if (xb_ld(&bar[XB_TMO])) break; if (sp > XB_SPIN_CAP) { atomicAdd(&bar[XB_TMO], 1u); break; } }
  }
  nloc = mine > 0u ? mine : 1u; nx = cnt > 0u ? cnt : 1u;
}
__device__ __forceinline__ void xcd_barrier(const XcdBarrier& b) {
  asm volatile("s_waitcnt vmcnt(0)" ::: "memory");
  __syncthreads();
  if (threadIdx.x == 0) {
    unsigned* bar = b.bar;
    __builtin_amdgcn_s_waitcnt(0);
    unsigned nloc = b.st[0], nx = b.st[1];
    if (nloc == 0u) { xcd_barrier_complete(bar, b.x, nloc, nx); b.st[0] = nloc; b.st[1] = nx; }
    const unsigned old = xb_add(&bar[XB_XSUB(b.x)], 1u);
    const unsigned gen = old / nloc;
    if (old + 1u == (gen + 1u) * nloc) {
      __builtin_amdgcn_fence(__ATOMIC_RELEASE, "agent");
      asm volatile("s_waitcnt vmcnt(0)" ::: "memory");
      const unsigned og = xb_add(&bar[XB_TOP], 1u);
      const unsigned tg = og / nx;
      if (og + 1u == (tg + 1u) * nx) xb_add(&bar[XB_TOPGEN], 1u);
      else XB_SPIN(xb_ld(&bar[XB_TOPGEN]) == tg, bar);
      __builtin_amdgcn_fence(__ATOMIC_ACQUIRE, "agent");
      xb_add(&bar[XB_XGEN(b.x)], 1u);
      asm volatile("s_waitcnt vmcnt(0)" ::: "memory");
    } else {
      XB_SPIN(xb_ld(&bar[XB_XGEN(b.x)]) == gen, bar);
      __builtin_amdgcn_fence(__ATOMIC_ACQUIRE, "agent");
      asm volatile("s_waitcnt vmcnt(0)" ::: "memory");
    }
  }
  __syncthreads();
}

#ifndef PROBE_PRE
#define PROBE_PRE 0
#endif
#define PROBE_X 0
__global__ void __launch_bounds__(256, 2) hybrid_mega(Params p, int ph_lo, int ph_hi) {
  __shared__ __attribute__((aligned(16))) char smem[SMEM_BYTES];
  __shared__ uint4 xb_words;
  cg::grid_group grid = cg::this_grid();
  if (threadIdx.x == 0) xb_words = make_uint4(0u, 0u, 0u, 0u);
  __syncthreads();
  XcdBarrier xb = xcd_barrier_post((unsigned*)(p.ws + OFF_XBAR), (volatile LAS unsigned*)&xb_words);
  if (PROBE_PRE > 0 && ph_hi - ph_lo > 1) {
    for (int ph = 0; ph < PROBE_PRE; ++ph) { run_phase(p, ph, smem); grid.sync(); }
    if (PROBE_X) { run_phase(p, 5, smem, PROBE_X); grid.sync(); }
  }
  for (int ph = ph_lo; ph < ph_hi; ++ph) {
    run_phase(p, ph, smem);
    if (ph + 1 < ph_hi) { if (ph_hi > 1000) grid.sync(); else xcd_barrier(xb); }
  }
}

extern "C" void kernel_launch(void* const* d_in, const int* in_sizes, int n_in, void* d_out, int out_size, void* d_ws,
                              size_t ws_size, hipStream_t stream) {
  static int grid_blocks = 0;
  if (!grid_blocks) {
    int dev = 0, cus = 0, per_cu = 0;
    hipGetDevice(&dev);
    hipDeviceGetAttribute(&cus, hipDeviceAttributeMultiprocessorCount, dev);
    hipOccupancyMaxActiveBlocksPerMultiprocessor(&per_cu, hybrid_mega, 256, 0);
    if (per_cu < 1) per_cu = 1;
    if (per_cu > 2) per_cu = 2;
    grid_blocks = cus * per_cu;
  }
  if (ws_size < WS_NEEDED) fprintf(stderr, "workspace too small: %zu < %zu\n", ws_size, (size_t)WS_NEEDED);
  Params p{};
  for (int i = 0; i < 35; ++i) p.in[i] = (const float*)d_in[i];
  p.out = (float*)d_out;
  p.ws = (char*)d_ws;
  hipMemsetAsync((char*)d_ws + OFF_XBAR, 0, XCD_BAR_WORDS * sizeof(unsigned), stream);
#if MEGA
  int lo = 0, hi = N_PHASES;
  void* args[] = {&p, &lo, &hi};
  hipError_t e = hipLaunchCooperativeKernel((void*)hybrid_mega, dim3(grid_blocks), dim3(256), args, 0, stream);
  if (e != hipSuccess) fprintf(stderr, "cooperative launch failed: %s (grid %d)\n", hipGetErrorString(e), grid_blocks);
#else
  for (int ph = 0; ph < N_PHASES; ++ph) hybrid_mega<<<grid_blocks, 256, 0, stream>>>(p, ph, ph + 1);
#endif
}
```

```cpp
#include <hip/hip_runtime.h>
#include <hip/hip_cooperative_groups.h>
#include <stdint.h>
#include <stdio.h>
namespace cg = cooperative_groups;

#ifndef MEGA
#define MEGA 1
#endif

typedef unsigned short bf16_t;
typedef __attribute__((ext_vector_type(8))) short bf16x8;
typedef __attribute__((ext_vector_type(16))) float f32x16;
typedef __attribute__((ext_vector_type(4))) float f32x4;

#define SEQ 4096
#define NTOK 32768
#define MIB ((size_t)1 << 20)

struct Params { const float* in[35]; float* out; char* ws; };

#define OFF_WT_IN(l)  ((size_t)(l) * 16 * MIB)
#define OFF_WT_UP(l)  (32 * MIB + (size_t)(l) * 3 * MIB)
#define OFF_WT_OUT(l) (38 * MIB + (size_t)(l) * 2 * MIB)
#define OFF_WT_GLU(l) (42 * MIB + (size_t)(l) * (MIB / 2))
#define OFF_WT_C1K(l) (43 * MIB + (size_t)(l) * MIB)
#define OFF_WT_C1V(l) (45 * MIB + (size_t)(l) * MIB)
#define OFF_WT_C2K(l) (47 * MIB + (size_t)(l) * 65536)
#define OFF_WT_C2V(l) (47 * MIB + 131072 + (size_t)(l) * 65536)
#define OFF_WT_LW(l)  (47 * MIB + 262144 + (size_t)(l) * 65536)
#define OFF_WT_LA(l)  (47 * MIB + 393216 + (size_t)(l) * 65536)
#define OFF_ROPE_C    (47 * MIB + 524288)
#define OFF_ROPE_S    (48 * MIB)
#define OFF_MOD       (48 * MIB + 524288)
#define OFF_S5AB      (48 * MIB + 786432)
#define OFF_S5BB      (48 * MIB + 786432 + 65536)
#define OFF_Q     (50 * MIB)
#define OFF_H2    (50 * MIB)
#define OFF_KS    (82 * MIB)
#define OFF_KW    (90 * MIB)
#define OFF_VST   (98 * MIB)
#define OFF_VWT   (106 * MIB)
#define OFF_KC    (114 * MIB)
#define OFF_VC    (122 * MIB)
#define OFF_NSAG  (130 * MIB)
#define OFF_S5U   (134 * MIB)
#define OFF_GATES (166 * MIB)
#define OFF_MIX   (262 * MIB)
#define OFF_MERGED (262 * MIB)
#define OFF_WLOG  (366 * MIB)
#define OFF_H1    (366 * MIB)
#define OFF_AA    (398 * MIB)
#define OFF_S5Y   (430 * MIB)
#define OFF_YRAW  (462 * MIB)
#define OFF_CMPHK (494 * MIB)
#define OFF_CMPHV (496 * MIB)
#define OFF_KCMP  (498 * MIB)
#define OFF_VCMPT (498 * MIB + 524288)
#define OFF_KNORM (500 * MIB)
#define OFF_XBAR (503 * MIB)
#define WS_NEEDED (504 * MIB)

#define SMEM_BYTES 78848
#define QSCALE 0.18033688011112042f

__device__ __forceinline__ int otid() { int t = threadIdx.x; asm volatile("" : "+v"(t)); return t; }
typedef __bf16 hbf2 __attribute__((ext_vector_type(2)));
typedef float hf2 __attribute__((ext_vector_type(2)));
__device__ __forceinline__ uint32_t pk2(float a, float b) {
  hf2 v = {a, b};
  return __builtin_bit_cast(uint32_t, __builtin_convertvector(v, hbf2));
}
__device__ __forceinline__ bf16_t f2bf(float f) { return (bf16_t)(pk2(f, 0.f) & 0xffffu); }
__device__ __forceinline__ float bf2f(bf16_t b) { return __uint_as_float(((uint32_t)b) << 16); }
__device__ __forceinline__ float lo_bf(uint32_t v) { return __uint_as_float(v << 16); }
__device__ __forceinline__ float hi_bf(uint32_t v) { return __uint_as_float(v & 0xffff0000u); }
__device__ __forceinline__ float sigmoidf_(float x) { return 1.f / (1.f + __expf(-x)); }
__device__ __forceinline__ float siluf_(float x) { return x / (1.f + __expf(-x)); }
__device__ __forceinline__ float tanhf_(float x) {
  float e = __expf(-2.f * fabsf(x));
  float t = (1.f - e) / (1.f + e);
  return x < 0.f ? -t : t;
}
__device__ __forceinline__ float geluf_(float x) {
  float u = 0.7978845608028654f * (x + 0.044715f * x * x * x);
  return 0.5f * x * (1.f + tanhf_(u));
}
__device__ __forceinline__ float ex2(float x) { return __builtin_amdgcn_exp2f(x); }
__device__ __forceinline__ float wave_sum_x(float x) {
#pragma unroll
  for (int o = 32; o > 0; o >>= 1) x += __shfl_xor(x, o);
  return x;
}
__device__ __forceinline__ float dpp_ror(float x, int) { return x; }
#define DPP_ADD(x, ctrl) x += __builtin_bit_cast(float, __builtin_amdgcn_update_dpp(0, __builtin_bit_cast(int, x), ctrl, 0xf, 0xf, false))
__device__ __forceinline__ float rr16(float x) {
  DPP_ADD(x, 0x128);
  DPP_ADD(x, 0x124);
  DPP_ADD(x, 0x122);
  DPP_ADD(x, 0x121);
  return x;
}
__device__ __forceinline__ float rr8(float x) {
  DPP_ADD(x, 0xB1);
  DPP_ADD(x, 0x4E);
  DPP_ADD(x, 0x141);
  return x;
}
__device__ __forceinline__ float wave_sum_d(float x) {
  x = rr16(x);
  int xi = __builtin_bit_cast(int, x);
  float s0 = __builtin_bit_cast(float, __builtin_amdgcn_readlane(xi, 0));
  float s1 = __builtin_bit_cast(float, __builtin_amdgcn_readlane(xi, 16));
  float s2 = __builtin_bit_cast(float, __builtin_amdgcn_readlane(xi, 32));
  float s3 = __builtin_bit_cast(float, __builtin_amdgcn_readlane(xi, 48));
  return (s0 + s1) + (s2 + s3);
}
__device__ __forceinline__ f32x16 mfma32(bf16x8 a, bf16x8 b, f32x16 c) {
  return __builtin_amdgcn_mfma_f32_32x32x16_bf16(a, b, c, 0, 0, 0);
}
__device__ __forceinline__ f32x4 mfma16(bf16x8 a, bf16x8 b, f32x4 c) {
  return __builtin_amdgcn_mfma_f32_16x16x32_bf16(a, b, c, 0, 0, 0);
}
__device__ __forceinline__ bf16x8 u4_to_frag(uint4 v) { return __builtin_bit_cast(bf16x8, v); }
__device__ __forceinline__ bf16x8 pack_frag(float a0, float a1, float a2, float a3, float a4, float a5, float a6, float a7) {
  uint4 v; v.x = pk2(a0, a1); v.y = pk2(a2, a3); v.z = pk2(a4, a5); v.w = pk2(a6, a7);
  return __builtin_bit_cast(bf16x8, v);
}

__device__ __forceinline__ void sincos_d(double x, double& s, double& c) {
  double rev = x * 0.15915494309189535;
  double fr = rev - rint(rev);
  double y = fr * 6.283185307179586 * 0.125;
  double y2 = y * y;
  s = y * (1.0 + y2 * (-1.0 / 6.0 + y2 * (1.0 / 120.0 + y2 * (-1.0 / 5040.0 + y2 * (1.0 / 362880.0 + y2 * (-1.0 / 39916800.0 + y2 * (1.0 / 6227020800.0)))))));
  c = 1.0 + y2 * (-0.5 + y2 * (1.0 / 24.0 + y2 * (-1.0 / 720.0 + y2 * (1.0 / 40320.0 + y2 * (-1.0 / 3628800.0 + y2 * (1.0 / 479001600.0 + y2 * (-1.0 / 87178291200.0)))))));
#pragma unroll
  for (int i = 0; i < 3; ++i) { double s2 = 2.0 * s * c, c2 = c * c - s * s; s = s2; c = c2; }
}

template <int NTW, bool SB = false, class AL, class BL>
__device__ __forceinline__ void gemm_loop(AL al, BL bl, int K, f32x16 (&acc)[2][NTW], char* smem) {
  const int tid = otid(), lane = tid & 63, wave = tid >> 6;
  const int wm = wave >> 1, wn = wave & 1, r = lane & 31, h = lane >> 5;
  uint4 ra0[4], rb0[4], ra1[4], rb1[4];
  const int nk = K >> 6;
  auto gload = [&](int kt, uint4 (&ra)[4], uint4 (&rb)[4]) __attribute__((always_inline)) {
    const int k0 = kt * 64;
#pragma unroll
    for (int i = 0; i < 4; ++i) {
      int id = tid + 256 * i;
      ra[i] = al(id >> 3, k0 + (id & 7) * 8);
      if (i < 2 * NTW) rb[i] = bl(id >> 3, k0 + (id & 7) * 8);
    }
  };
  auto lwrite = [&](int buf, uint4 (&ra)[4], uint4 (&rb)[4]) __attribute__((always_inline)) {
    bf16_t* As = (bf16_t*)smem + buf * (256 * 72);
    bf16_t* Bs = As + 128 * 72;
#pragma unroll
    for (int i = 0; i < 4; ++i) {
      int id = tid + 256 * i;
      *(uint4*)&As[(id >> 3) * 72 + (id & 7) * 8] = ra[i];
      if (i < 2 * NTW) *(uint4*)&Bs[(id >> 3) * 72 + (id & 7) * 8] = rb[i];
    }
  };
  auto compute = [&](int buf) __attribute__((always_inline)) {
    const bf16_t* As = (const bf16_t*)smem + buf * (256 * 72);
    const bf16_t* Bs = As + 128 * 72;
#pragma unroll
    for (int ks = 0; ks < 4; ++ks) {
      bf16x8 a0 = *(const bf16x8*)&As[(wm * 64 + r) * 72 + ks * 16 + h * 8];
      bf16x8 a1 = *(const bf16x8*)&As[(wm * 64 + 32 + r) * 72 + ks * 16 + h * 8];
#pragma unroll
      for (int nt = 0; nt < NTW; ++nt) {
        bf16x8 b0 = *(const bf16x8*)&Bs[(wn * 32 * NTW + nt * 32 + r) * 72 + ks * 16 + h * 8];
        acc[0][nt] = mfma32(a0, b0, acc[0][nt]);
        acc[1][nt] = mfma32(a1, b0, acc[1][nt]);
      }
    }
  };
  if (SB) {
    gload(0, ra0, rb0);
    for (int kt = 0; kt < nk; ++kt) {
      __syncthreads();
      lwrite(0, ra0, rb0);
      __syncthreads();
      gload(min(kt + 1, nk - 1), ra0, rb0);
      compute(0);
    }
    return;
  }
  gload(0, ra0, rb0);
  gload(min(1, nk - 1), ra1, rb1);
  __syncthreads();
  lwrite(0, ra0, rb0);
  __syncthreads();
  for (int kt = 0; kt < nk; kt += 2) {
    gload(min(kt + 2, nk - 1), ra0, rb0);
    compute(0);
    if (kt + 1 < nk) lwrite(1, ra1, rb1);
    __syncthreads();
    if (kt + 1 < nk) {
      gload(min(kt + 3, nk - 1), ra1, rb1);
      compute(1);
      if (kt + 2 < nk) lwrite(0, ra0, rb0);
      __syncthreads();
    }
  }
}
template <class AL, class BL>
__device__ __forceinline__ void gemm_loop_big(AL al, BL bl, int K, f32x16 (&acc)[4][2], char* smem) {
  const int tid = otid(), lane = tid & 63, wave = tid >> 6;
  const int wm = wave >> 1, wn = wave & 1, r = lane & 31, h = lane >> 5;
  bf16_t* As = (bf16_t*)smem;
  bf16_t* Bs = As + 256 * 72;
  uint4 ra[8], rb[4];
  const int nk = K >> 6;
#pragma unroll
  for (int i = 0; i < 8; ++i) { int id = tid + 256 * i; ra[i] = al(id >> 3, (id & 7) * 8); }
#pragma unroll
  for (int i = 0; i < 4; ++i) { int id = tid + 256 * i; rb[i] = bl(id >> 3, (id & 7) * 8); }
  for (int kt = 0; kt < nk; ++kt) {
    __syncthreads();
#pragma unroll
    for (int i = 0; i < 8; ++i) { int id = tid + 256 * i; *(uint4*)&As[(id >> 3) * 72 + (id & 7) * 8] = ra[i]; }
#pragma unroll
    for (int i = 0; i < 4; ++i) { int id = tid + 256 * i; *(uint4*)&Bs[(id >> 3) * 72 + (id & 7) * 8] = rb[i]; }
    __syncthreads();
    {
      const int k0 = min(kt + 1, nk - 1) * 64;
#pragma unroll
      for (int i = 0; i < 8; ++i) { int id = tid + 256 * i; ra[i] = al(id >> 3, k0 + (id & 7) * 8); }
#pragma unroll
      for (int i = 0; i < 4; ++i) { int id = tid + 256 * i; rb[i] = bl(id >> 3, k0 + (id & 7) * 8); }
    }
#pragma unroll
    for (int ks = 0; ks < 4; ++ks) {
      bf16x8 b0 = *(const bf16x8*)&Bs[(wn * 64 + r) * 72 + ks * 16 + h * 8];
      bf16x8 b1 = *(const bf16x8*)&Bs[(wn * 64 + 32 + r) * 72 + ks * 16 + h * 8];
#pragma unroll
      for (int mt = 0; mt < 4; ++mt) {
        bf16x8 a = *(const bf16x8*)&As[(wm * 128 + mt * 32 + r) * 72 + ks * 16 + h * 8];
        acc[mt][0] = mfma32(a, b0, acc[mt][0]);
        acc[mt][1] = mfma32(a, b1, acc[mt][1]);
      }
    }
  }
}
template <int NTW>
__device__ __forceinline__ void zero_acc(f32x16 (&acc)[2][NTW]) {
#pragma unroll
  for (int a = 0; a < 2; ++a)
#pragma unroll
    for (int b = 0; b < NTW; ++b)
#pragma unroll
      for (int i = 0; i < 16; ++i) acc[a][b][i] = 0.f;
}
template <int MT, class EP>
__device__ __forceinline__ void gemm_epi(f32x16 (&acc)[MT][2], int m0, int n0, EP ep) {
  const int lane = otid() & 63, wave = otid() >> 6;
  const int wm = wave >> 1, wn = wave & 1, r = lane & 31, h = lane >> 5;
#pragma unroll
  for (int mt = 0; mt < MT; ++mt)
#pragma unroll
    for (int qd = 0; qd < 4; ++qd) {
      int row0 = m0 + wm * (MT * 32) + mt * 32 + 8 * qd + 4 * h;
      int col = n0 + wn * 64 + r;
      ep(row0, col, acc[mt][0][4 * qd], acc[mt][0][4 * qd + 1], acc[mt][0][4 * qd + 2], acc[mt][0][4 * qd + 3],
         acc[mt][1][4 * qd], acc[mt][1][4 * qd + 1], acc[mt][1][4 * qd + 2], acc[mt][1][4 * qd + 3]);
    }
}

__device__ __forceinline__ int win_map(int n2) {
  if (n2 < 1280) return n2;
  if (n2 < 1792) return 1304 + (n2 - 1280);
  if (n2 < 2304) return 2328 + (n2 - 1792);
  if (n2 < 2816) return 4504 + (n2 - 2304);
  if (n2 < 3328) return 1816 + (n2 - 2816);
  if (n2 < 4992) return 2840 + (n2 - 3328);
  if (n2 < 5016) return 1280 + (n2 - 4992);
  if (n2 < 5120) return -1;
  return 5016 + (n2 - 5120);
}
__device__ __forceinline__ void tconv(const float* __restrict__ src, int K, int Nsrc, bf16_t* dst, int Ndst, int mapkind, int gtid, int gsize) {
  int total = Ndst * (K >> 3);
  for (int idx = gtid; idx < total; idx += gsize) {
    int n2 = idx % Ndst, k8 = idx / Ndst;
    int n = mapkind ? win_map(n2) : (n2 < Nsrc ? n2 : -1);
    uint4 o = make_uint4(0, 0, 0, 0);
    if (n >= 0) {
      const float* s = src + (size_t)(k8 * 8) * Nsrc + n;
      float v0 = s[0], v1 = s[Nsrc], v2 = s[2 * (size_t)Nsrc], v3 = s[3 * (size_t)Nsrc];
      float v4 = s[4 * (size_t)Nsrc], v5 = s[5 * (size_t)Nsrc], v6 = s[6 * (size_t)Nsrc], v7 = s[7 * (size_t)Nsrc];
      o.x = pk2(v0, v1); o.y = pk2(v2, v3); o.z = pk2(v4, v5); o.w = pk2(v6, v7);
    }
    *(uint4*)(dst + (size_t)n2 * K + k8 * 8) = o;
  }
}

__device__ __forceinline__ void phase_prep(const Params& p, char* smem) {
  const int tid = otid();
  const int gtid = blockIdx.x * 256 + tid, gsize = gridDim.x * 256;
  char* ws = p.ws;
  for (int task = blockIdx.x; task < 96; task += gridDim.x) {
    float* cond = (float*)smem;
    float* red = cond + 8192;
    __syncthreads();
    for (int i = tid; i < 8192; i += 256) cond[i] = siluf_(p.in[1][i]);
    __syncthreads();
    int l = task / 48, cg_ = task % 48;
    int kc = tid >> 6, n = tid & 63, col = cg_ * 64 + n;
    float a[8];
#pragma unroll
    for (int b = 0; b < 8; ++b) a[b] = 0.f;
    const float* mw = p.in[3] + (size_t)l * 1024 * 3072 + col;
    for (int k = kc * 256; k < kc * 256 + 256; ++k) {
      float w = mw[(size_t)k * 3072];
#pragma unroll
      for (int b = 0; b < 8; ++b) a[b] += cond[b * 1024 + k] * w;
    }
#pragma unroll
    for (int b = 0; b < 8; ++b) red[(kc * 8 + b) * 64 + n] = a[b];
    __syncthreads();
    for (int i = tid; i < 512; i += 256) {
      int b = i >> 6, nn = i & 63;
      float v = red[(0 * 8 + b) * 64 + nn] + red[(1 * 8 + b) * 64 + nn] + red[(2 * 8 + b) * 64 + nn] + red[(3 * 8 + b) * 64 + nn];
      int cc = cg_ * 64 + nn;
      ((float*)(ws + OFF_MOD))[(size_t)(l * 8 + b) * 3072 + cc] = v + p.in[4][l * 3072 + cc];
    }
  }
  for (int idx = gtid; idx < 4096 * 32; idx += gsize) {
    int s = idx >> 5, d = idx & 31;
    float inv = expf(-9.210340371976184f * (float)d / 32.f);
    double ang = (double)s * (double)inv, sn, cs;
    sincos_d(ang, sn, cs);
    ((float*)(ws + OFF_ROPE_C))[idx] = (float)cs;
    ((float*)(ws + OFF_ROPE_S))[idx] = (float)sn;
  }
  for (int idx = gtid; idx < 2 * 32 * 64; idx += gsize) {
    int l = idx >> 11, g = (idx >> 6) & 31, pp = idx & 63;
    double are = p.in[12][idx], aim = p.in[13][idx];
    double dt = exp((double)p.in[19][l * 32 + g]);
    double mag = exp(are * dt), sn, cs;
    sincos_d(aim * dt, sn, cs);
    double abr = mag * cs, abi = mag * sn;
    ((float*)(ws + OFF_S5AB))[idx * 2] = (float)abr;
    ((float*)(ws + OFF_S5AB))[idx * 2 + 1] = (float)abi;
    double nr = abr - 1.0, ni = abi, den = are * are + aim * aim;
    double cr = (nr * are + ni * aim) / den, ci = (ni * are - nr * aim) / den;
    bf16_t* bb = (bf16_t*)(ws + OFF_S5BB) + (size_t)(l * 32 + g) * 2 * 64 * 16;
    for (int c = 0; c < 16; ++c) {
      double br = p.in[14][(size_t)idx * 16 + c], bi = p.in[15][(size_t)idx * 16 + c];
      bb[(0 * 64 + pp) * 16 + c] = f2bf((float)(cr * br - ci * bi));
      bb[(1 * 64 + pp) * 16 + c] = f2bf((float)(cr * bi + ci * br));
    }
  }
  for (int job = 0; job < 24; ++job) {
    const int l = job / 12, j = job % 12;
    const float* src; bf16_t* dst; int K, Nsrc, Ndst, mk = 0;
    switch (j) {
      case 0: src = p.in[5] + (size_t)l * 1024 * 8088; K = 1024; Nsrc = 8088; dst = (bf16_t*)(ws + OFF_WT_IN(l)); Ndst = 8192; mk = 1; break;
      case 1: case 2: case 3:
        src = p.in[32] + (size_t)(l * 3 + (j - 1)) * 512 * 1024; K = 512; Nsrc = 1024;
        dst = (bf16_t*)(ws + OFF_WT_UP(l)) + (size_t)(j - 1) * 1024 * 512; Ndst = 1024; break;
      case 4: src = p.in[33] + (size_t)l * 1024 * 1024; K = 1024; Nsrc = 1024; dst = (bf16_t*)(ws + OFF_WT_OUT(l)); Ndst = 1024; break;
      case 5: src = p.in[20] + (size_t)l * 512 * 512; K = 512; Nsrc = 512; dst = (bf16_t*)(ws + OFF_WT_GLU(l)); Ndst = 512; break;
      case 6: src = p.in[8] + (size_t)l * 2048 * 256; K = 2048; Nsrc = 256; dst = (bf16_t*)(ws + OFF_WT_C1K(l)); Ndst = 256; break;
      case 7: src = p.in[10] + (size_t)l * 2048 * 256; K = 2048; Nsrc = 256; dst = (bf16_t*)(ws + OFF_WT_C1V(l)); Ndst = 256; break;
      case 8: src = p.in[9] + (size_t)l * 256 * 64; K = 256; Nsrc = 64; dst = (bf16_t*)(ws + OFF_WT_C2K(l)); Ndst = 128; break;
      case 9: src = p.in[11] + (size_t)l * 256 * 64; K = 256; Nsrc = 64; dst = (bf16_t*)(ws + OFF_WT_C2V(l)); Ndst = 128; break;
      case 10: src = p.in[24] + (size_t)l * 64 * 512; K = 64; Nsrc = 512; dst = (bf16_t*)(ws + OFF_WT_LW(l)); Ndst = 512; break;
      default: src = p.in[26] + (size_t)l * 64 * 512; K = 64; Nsrc = 512; dst = (bf16_t*)(ws + OFF_WT_LA(l)); Ndst = 512; break;
    }
    tconv(src, K, Nsrc, dst, Ndst, mk, gtid, gsize);
  }
}

template <int R>
__device__ __forceinline__ void norm_rows(const Params& p, int l, int row0, bf16_t* H) {
  const int lane = otid() & 63;
  const float* xb = (l == 0 ? p.in[0] : p.out);
  float4 v[R][4];
  float ss[R];
#pragma unroll
  for (int u = 0; u < R; ++u) {
    const float* xs = xb + (size_t)(row0 + u) * 1024;
    ss[u] = 0.f;
#pragma unroll
    for (int i = 0; i < 4; ++i) v[u][i] = *(const float4*)(xs + lane * 4 + 256 * i);
  }
  const float* nw = p.in[2] + l * 1024;
#pragma unroll
  for (int u = 0; u < R; ++u) {
#pragma unroll
    for (int i = 0; i < 4; ++i) ss[u] += v[u][i].x * v[u][i].x + v[u][i].y * v[u][i].y + v[u][i].z * v[u][i].z + v[u][i].w * v[u][i].w;
    ss[u] = wave_sum_x(ss[u]);
    float rr = rsqrtf(ss[u] * (1.f / 1024.f) + 1e-6f);
    int b = (row0 + u) >> 12;
    const float* md = (const float*)(p.ws + OFF_MOD) + (size_t)(l * 8 + b) * 3072;
#pragma unroll
    for (int i = 0; i < 4; ++i) {
      int d = lane * 4 + 256 * i;
      float4 w = *(const float4*)(nw + d);
      float4 sh = *(const float4*)(md + d);
      float4 sc = *(const float4*)(md + 1024 + d);
      float h0 = v[u][i].x * rr * w.x * (1.f + sc.x) + sh.x;
      float h1 = v[u][i].y * rr * w.y * (1.f + sc.y) + sh.y;
      float h2 = v[u][i].z * rr * w.z * (1.f + sc.z) + sh.z;
      float h3 = v[u][i].w * rr * w.w * (1.f + sc.w) + sh.w;
      uint2 o; o.x = pk2(h0, h1); o.y = pk2(h2, h3);
      *(uint2*)(H + (size_t)(row0 + u) * 1024 + d) = o;
    }
  }
}
template <int R>
__device__ __forceinline__ void final_norm_rows(const Params& p, int row0) {
  const int lane = otid() & 63;
  float4 v[R][4];
#pragma unroll
  for (int u = 0; u < R; ++u)
#pragma unroll
    for (int i = 0; i < 4; ++i) v[u][i] = *(const float4*)(p.out + (size_t)(row0 + u) * 1024 + lane * 4 + 256 * i);
#pragma unroll
  for (int u = 0; u < R; ++u) {
    float ss = 0.f;
#pragma unroll
    for (int i = 0; i < 4; ++i) ss += v[u][i].x * v[u][i].x + v[u][i].y * v[u][i].y + v[u][i].z * v[u][i].z + v[u][i].w * v[u][i].w;
    ss = wave_sum_x(ss);
    float rr = rsqrtf(ss * (1.f / 1024.f) + 1e-6f);
#pragma unroll
    for (int i = 0; i < 4; ++i) {
      int d = lane * 4 + 256 * i;
      float4 w = *(const float4*)(p.in[34] + d);
      float4 o = make_float4(v[u][i].x * rr * w.x, v[u][i].y * rr * w.y, v[u][i].z * rr * w.z, v[u][i].w * rr * w.w);
      *(float4*)(p.out + (size_t)(row0 + u) * 1024 + d) = o;
    }
  }
}

__device__ __forceinline__ void proj_tile(const Params& p, int l, int tile, char* smem) {
  char* ws = p.ws;
  const int m0 = (tile / 40) * 256, n0 = (tile % 40) * 128;
  const bf16_t* A = (const bf16_t*)(ws + OFF_H1) + (size_t)m0 * 1024;
  const bf16_t* B = (const bf16_t*)(ws + OFF_WT_IN(l)) + (size_t)n0 * 1024;
  f32x16 acc[4][2];
#pragma unroll
  for (int a_ = 0; a_ < 4; ++a_)
#pragma unroll
    for (int b_ = 0; b_ < 2; ++b_)
#pragma unroll
      for (int i_ = 0; i_ < 16; ++i_) acc[a_][b_][i_] = 0.f;
  gemm_loop_big([=](int row, int k) __attribute__((always_inline)) { return *(const uint4*)(A + (uint32_t)(row * 1024 + k)); },
            [=](int row, int k) __attribute__((always_inline)) { return *(const uint4*)(B + (uint32_t)(row * 1024 + k)); }, 1024, acc, smem);
  const float* ropeC = (const float*)(ws + OFF_ROPE_C);
  const float* ropeS = (const float*)(ws + OFF_ROPE_S);
  const int lane = otid() & 63, wn = (otid() >> 6) & 1, r = lane & 31;
  if (n0 < 512) {
    bf16_t* Q = (bf16_t*)(ws + OFF_Q);
    const int wm_ = otid() >> 7, h_ = lane >> 5;
#pragma unroll
    for (int mt = 0; mt < 4; ++mt) {
      float rcs[4][4], rsn[4][4];
#pragma unroll
      for (int qd = 0; qd < 4; ++qd)
#pragma unroll
        for (int j = 0; j < 4; ++j) {
          int s_ = (m0 + wm_ * 128 + mt * 32 + 8 * qd + 4 * h_ + j) & 4095;
          rcs[qd][j] = ropeC[s_ * 32 + r];
          rsn[qd][j] = ropeS[s_ * 32 + r];
        }
#pragma unroll
      for (int qd = 0; qd < 4; ++qd)
#pragma unroll
        for (int j = 0; j < 4; ++j) {
          int row = m0 + wm_ * 128 + mt * 32 + 8 * qd + 4 * h_ + j, col = n0 + wn * 64 + r;
          float cs = rcs[qd][j], sn = rsn[qd][j];
          float a_ = acc[mt][0][4 * qd + j], b_ = acc[mt][1][4 * qd + j];
          Q[(size_t)row * 512 + col] = f2bf((a_ * cs - b_ * sn) * QSCALE);
          Q[(size_t)row * 512 + col + 32] = f2bf((a_ * sn + b_ * cs) * QSCALE);
        }
    }
  } else if (n0 < 1280) {
    const int part = (n0 - 512) >> 7, g = wn;
    if ((part & 1) == 0) {
      bf16_t* Kb = (bf16_t*)(ws + (part == 0 ? OFF_KC : (part == 2 ? OFF_KS : OFF_KW)));
      const int wm_ = otid() >> 7, h_ = lane >> 5;
#pragma unroll
      for (int mt = 0; mt < 4; ++mt) {
        float rcs[4][4], rsn[4][4];
#pragma unroll
        for (int qd = 0; qd < 4; ++qd)
#pragma unroll
          for (int j = 0; j < 4; ++j) {
            int s_ = (m0 + wm_ * 128 + mt * 32 + 8 * qd + 4 * h_ + j) & 4095;
            rcs[qd][j] = ropeC[s_ * 32 + r];
            rsn[qd][j] = ropeS[s_ * 32 + r];
          }
#pragma unroll
        for (int qd = 0; qd < 4; ++qd)
#pragma unroll
          for (int j = 0; j < 4; ++j) {
            int row = m0 + wm_ * 128 + mt * 32 + 8 * qd + 4 * h_ + j, s_ = row & 4095, b_i = row >> 12;
            float cs = rcs[qd][j], sn = rsn[qd][j];
            float a_ = acc[mt][0][4 * qd + j], b_ = acc[mt][1][4 * qd + j];
            size_t o = ((size_t)(b_i * 2 + g) * 4096 + s_) * 64 + r;
            Kb[o] = f2bf(a_ * cs - b_ * sn);
            Kb[o + 32] = f2bf(a_ * sn + b_ * cs);
          }
      }
    } else if (part == 1) {
      bf16_t* Vb = (bf16_t*)(ws + OFF_VC);
      gemm_epi(acc, m0, n0, [=](int row0, int col, float a0, float a1, float a2, float a3, float b0, float b1, float b2, float b3) __attribute__((always_inline)) {
        float av[4] = {a0, a1, a2, a3}, bv[4] = {b0, b1, b2, b3};
#pragma unroll
        for (int j = 0; j < 4; ++j) {
          int row = row0 + j, s = row & 4095, b = row >> 12;
          size_t o = ((size_t)(b * 2 + g) * 4096 + s) * 64 + r;
          Vb[o] = f2bf(av[j]);
          Vb[o + 32] = f2bf(bv[j]);
        }
      });
    } else {
      bf16_t* Vt = (bf16_t*)(ws + (part == 3 ? OFF_VST : OFF_VWT));
      gemm_epi(acc, m0, n0, [=](int row0, int col, float a0, float a1, float a2, float a3, float b0, float b1, float b2, float b3) __attribute__((always_inline)) {
        int s = row0 & 4095, b = row0 >> 12;
        size_t o = ((size_t)(b * 2 + g) * 64 + r) * 4096 + s;
        uint2 v; v.x = pk2(a0, a1); v.y = pk2(a2, a3);
        *(uint2*)(Vt + o) = v;
        uint2 w; w.x = pk2(b0, b1); w.y = pk2(b2, b3);
        *(uint2*)(Vt + o + (size_t)32 * 4096) = w;
      });
    }
  } else if (n0 < 2816) {
    bf16_t* G = (bf16_t*)(ws + OFF_GATES);
    gemm_epi(acc, m0, n0, [=](int row0, int col, float a0, float a1, float a2, float a3, float b0, float b1, float b2, float b3) __attribute__((always_inline)) {
      float av[4] = {a0, a1, a2, a3}, bv[4] = {b0, b1, b2, b3};
#pragma unroll
      for (int j = 0; j < 4; ++j) {
        size_t o = (size_t)(row0 + j) * 1536 + (col - 1280);
        G[o] = f2bf(siluf_(av[j]));
        G[o + 32] = f2bf(siluf_(bv[j]));
      }
    });
  } else if (n0 < 3328) {
    bf16_t* U = (bf16_t*)(ws + OFF_S5U);
    gemm_epi(acc, m0, n0, [=](int row0, int col, float a0, float a1, float a2, float a3, float b0, float b1, float b2, float b3) __attribute__((always_inline)) {
      float av[4] = {a0, a1, a2, a3}, bv[4] = {b0, b1, b2, b3};
#pragma unroll
      for (int j = 0; j < 4; ++j) {
        size_t o = (size_t)(row0 + j) * 512 + (col - 2816);
        U[o] = f2bf(av[j]);
        U[o + 32] = f2bf(bv[j]);
      }
    });
  } else if (n0 < 4992) {
    bf16_t* X = (bf16_t*)(ws + OFF_MIX);
    gemm_epi(acc, m0, n0, [=](int row0, int col, float a0, float a1, float a2, float a3, float b0, float b1, float b2, float b3) __attribute__((always_inline)) {
      float av[4] = {a0, a1, a2, a3}, bv[4] = {b0, b1, b2, b3};
#pragma unroll
      for (int j = 0; j < 4; ++j) {
        size_t o = (size_t)(row0 + j) * 1664 + (col - 3328);
        X[o] = f2bf(av[j]);
        X[o + 32] = f2bf(bv[j]);
      }
    });
  } else {
    float* NG = (float*)(ws + OFF_NSAG);
    gemm_epi(acc, m0, n0, [=](int row0, int col, float a0, float a1, float a2, float a3, float b0, float b1, float b2, float b3) __attribute__((always_inline)) {
      int c = col - 4992;
      if (c < 24) {
        NG[(size_t)(row0 + 0) * 32 + c] = a0;
        NG[(size_t)(row0 + 1) * 32 + c] = a1;
        NG[(size_t)(row0 + 2) * 32 + c] = a2;
        NG[(size_t)(row0 + 3) * 32 + c] = a3;
      }
    });
  }
}

__device__ __forceinline__ void cmp1_tile(const Params& p, int l, int tile, char* smem) {
  char* ws = p.ws;
  const int isv = tile >> 6, t2 = tile & 63;
  const int m0 = (t2 >> 1) * 128, n0 = (t2 & 1) * 128;
  const bf16_t* src = (const bf16_t*)(ws + (isv ? OFF_VC : OFF_KC));
  const float* pos = p.in[isv ? 7 : 6] + (size_t)l * 2048;
  const bf16_t* B = (const bf16_t*)(ws + (isv ? OFF_WT_C1V(l) : OFF_WT_C1K(l))) + (size_t)n0 * 2048;
  f32x16 acc[2][2];
  zero_acc<2>(acc);
  gemm_loop<2>(
      [=](int row, int k) __attribute__((always_inline)) {
        int R = m0 + row, bg = R >> 8, n = R & 255;
        uint4 o = make_uint4(0, 0, 0, 0);
        if (n < 255) {
          int j = k >> 6, d = k & 63;
          uint4 v = *(const uint4*)(src + ((size_t)bg * 4096 + 16 * n + j) * 64 + d);
          float4 p0 = *(const float4*)(pos + k), p1 = *(const float4*)(pos + k + 4);
          o.x = pk2(lo_bf(v.x) + p0.x, hi_bf(v.x) + p0.y);
          o.y = pk2(lo_bf(v.y) + p0.z, hi_bf(v.y) + p0.w);
          o.z = pk2(lo_bf(v.z) + p1.x, hi_bf(v.z) + p1.y);
          o.w = pk2(lo_bf(v.w) + p1.z, hi_bf(v.w) + p1.w);
        }
        return o;
      },
      [=](int row, int k) __attribute__((always_inline)) { return *(const uint4*)(B + (uint32_t)(row * 2048 + k)); }, 2048, acc, smem);
  bf16_t* Hd = (bf16_t*)(ws + (isv ? OFF_CMPHV : OFF_CMPHK));
  gemm_epi(acc, m0, n0, [=](int row0, int col, float a0, float a1, float a2, float a3, float b0, float b1, float b2, float b3) __attribute__((always_inline)) {
    float av[4] = {a0, a1, a2, a3}, bv[4] = {b0, b1, b2, b3};
#pragma unroll
    for (int j = 0; j < 4; ++j) {
      size_t o = (size_t)(row0 + j) * 256 + col;
      Hd[o] = f2bf(siluf_(av[j]));
      Hd[o + 32] = f2bf(siluf_(bv[j]));
    }
  });
}
__device__ __forceinline__ void cmp2_tile(const Params& p, int l, int tile, char* smem) {
  char* ws = p.ws;
  const int isv = tile >> 5, m0 = (tile & 31) * 128;
  const bf16_t* A = (const bf16_t*)(ws + (isv ? OFF_CMPHV : OFF_CMPHK)) + (size_t)m0 * 256;
  const bf16_t* B = (const bf16_t*)(ws + (isv ? OFF_WT_C2V(l) : OFF_WT_C2K(l)));
  f32x16 acc[2][2];
  zero_acc<2>(acc);
  gemm_loop<2>([=](int row, int k) __attribute__((always_inline)) { return *(const uint4*)(A + (uint32_t)(row * 256 + k)); },
            [=](int row, int k) __attribute__((always_inline)) { return *(const uint4*)(B + (uint32_t)(row * 256 + k)); }, 256, acc, smem);
  const int wn = (otid() >> 6) & 1;
  if (wn == 0) {
    if (!isv) {
      bf16_t* D = (bf16_t*)(ws + OFF_KCMP);
      gemm_epi(acc, m0, 0, [=](int row0, int col, float a0, float a1, float a2, float a3, float b0, float b1, float b2, float b3) __attribute__((always_inline)) {
        float av[4] = {a0, a1, a2, a3}, bv[4] = {b0, b1, b2, b3};
#pragma unroll
        for (int j = 0; j < 4; ++j) {
          D[(size_t)(row0 + j) * 64 + col] = f2bf(av[j]);
          D[(size_t)(row0 + j) * 64 + col + 32] = f2bf(bv[j]);
        }
      });
    } else {
      bf16_t* D = (bf16_t*)(ws + OFF_VCMPT);
      gemm_epi(acc, m0, 0, [=](int row0, int col, float a0, float a1, float a2, float a3, float b0, float b1, float b2, float b3) __attribute__((always_inline)) {
        int bg = row0 >> 8, n = row0 & 255;
        size_t o = ((size_t)bg * 64 + col) * 256 + n;
        uint2 v; v.x = pk2(a0, a1); v.y = pk2(a2, a3);
        *(uint2*)(D + o) = v;
        uint2 w; w.x = pk2(b0, b1); w.y = pk2(b2, b3);
        *(uint2*)(D + o + 32 * 256) = w;
      });
    }
  }
}

__device__ __forceinline__ void lora_tile(const Params& p, int l, int tile, char* smem) {
  char* ws = p.ws;
  const int isa = tile >> 10, t2 = tile & 1023;
  const int m0 = (t2 >> 2) * 128, n0 = (t2 & 3) * 128;
  const bf16_t* MX = (const bf16_t*)(ws + OFF_MIX);
  const float* mu = p.in[22] + (size_t)l * 1664 + (isa ? 1600 : 1536);
  const int coff = isa ? 1600 : 1536;
  const bf16_t* B = (const bf16_t*)(ws + (isa ? OFF_WT_LA(l) : OFF_WT_LW(l))) + (size_t)n0 * 64;
  f32x16 acc[2][2];
  zero_acc<2>(acc);
  gemm_loop<2>(
      [=](int row, int k) __attribute__((always_inline)) {
        int tok = m0 + row;
        uint4 c = *(const uint4*)(MX + (size_t)tok * 1664 + coff + k);
        uint4 pv = make_uint4(0, 0, 0, 0);
        if ((tok & 4095) != 0) pv = *(const uint4*)(MX + (size_t)(tok - 1) * 1664 + coff + k);
        float4 m0_ = *(const float4*)(mu + k), m1_ = *(const float4*)(mu + k + 4);
        float v[8];
        v[0] = lo_bf(c.x) + (lo_bf(pv.x) - lo_bf(c.x)) * m0_.x;
        v[1] = hi_bf(c.x) + (hi_bf(pv.x) - hi_bf(c.x)) * m0_.y;
        v[2] = lo_bf(c.y) + (lo_bf(pv.y) - lo_bf(c.y)) * m0_.z;
        v[3] = hi_bf(c.y) + (hi_bf(pv.y) - hi_bf(c.y)) * m0_.w;
        v[4] = lo_bf(c.z) + (lo_bf(pv.z) - lo_bf(c.z)) * m1_.x;
        v[5] = hi_bf(c.z) + (hi_bf(pv.z) - hi_bf(c.z)) * m1_.y;
        v[6] = lo_bf(c.w) + (lo_bf(pv.w) - lo_bf(c.w)) * m1_.z;
        v[7] = hi_bf(c.w) + (hi_bf(pv.w) - hi_bf(c.w)) * m1_.w;
        if (!isa) {
#pragma unroll
          for (int j = 0; j < 8; ++j) v[j] = tanhf_(v[j]);
        }
        uint4 o; o.x = pk2(v[0], v[1]); o.y = pk2(v[2], v[3]); o.z = pk2(v[4], v[5]); o.w = pk2(v[6], v[7]);
        return o;
      },
      [=](int row, int k) __attribute__((always_inline)) { return *(const uint4*)(B + (uint32_t)(row * 64 + k)); }, 64, acc, smem);
  if (!isa) {
    bf16_t* D = (bf16_t*)(ws + OFF_WLOG);
    const float* w0 = p.in[23] + l * 512;
    const int c_ = n0 + ((otid() >> 6) & 1) * 64 + (otid() & 31);
    const float wa = w0[c_], wb = w0[c_ + 32];
    gemm_epi(acc, m0, n0, [=](int row0, int col, float a0, float a1, float a2, float a3, float b0, float b1, float b2, float b3) __attribute__((always_inline)) {
      float av[4] = {a0, a1, a2, a3}, bv[4] = {b0, b1, b2, b3};
#pragma unroll
      for (int j = 0; j < 4; ++j) {
        float z = -(wa + av[j]);
        float sp = fmaxf(z, 0.f) + log1pf(__expf(-fabsf(z)));
        float ld = -__expf(-sp - 0.5f);
        D[(size_t)(row0 + j) * 512 + col] = f2bf(ld);
        z = -(wb + bv[j]);
        sp = fmaxf(z, 0.f) + log1pf(__expf(-fabsf(z)));
        ld = -__expf(-sp - 0.5f);
        D[(size_t)(row0 + j) * 512 + col + 32] = f2bf(ld);
      }
    });
  } else {
    bf16_t* D = (bf16_t*)(ws + OFF_AA);
    const float* a0p = p.in[25] + l * 512;
    const int c_ = n0 + ((otid() >> 6) & 1) * 64 + (otid() & 31);
    const float wa = a0p[c_], wb = a0p[c_ + 32];
    gemm_epi(acc, m0, n0, [=](int row0, int col, float a0, float a1, float a2, float a3, float b0, float b1, float b2, float b3) __attribute__((always_inline)) {
      float av[4] = {a0, a1, a2, a3}, bv[4] = {b0, b1, b2, b3};
#pragma unroll
      for (int j = 0; j < 4; ++j) {
        D[(size_t)(row0 + j) * 512 + col] = f2bf(sigmoidf_(wa + av[j]));
        D[(size_t)(row0 + j) * 512 + col + 32] = f2bf(sigmoidf_(wb + bv[j]));
      }
    });
  }
}

__device__ __forceinline__ void s5_scan(const Params& p, int l, int task, char* smem) {
  char* ws = p.ws;
  const int tid = otid(), lane = tid & 63, wave = tid >> 6;
  const int wt = task * 4 + wave, bp = wt >> 5, g = wt & 31;
  uint32_t* Xl = (uint32_t*)smem + wave * (2 * 16 * 68);
  const int r = lane & 31, hq = lane >> 5;
  const bf16_t* BBp = (const bf16_t*)(ws + OFF_S5BB) + (size_t)(l * 32 + g) * 2 * 64 * 16;
  bf16x8 bfr[4];
#pragma unroll
  for (int j = 0; j < 4; ++j) {
    int ri = j & 1, pp = r + 32 * (j >> 1);
    bfr[j] = *(const bf16x8*)(BBp + (ri * 64 + pp) * 16 + hq * 8);
  }
  const float* ABp = (const float*)(ws + OFF_S5AB) + (size_t)(l * 32 + g) * 128;
  const float a0r = ABp[r * 2], a0i = ABp[r * 2 + 1], a1r = ABp[(32 + r) * 2], a1i = ABp[(32 + r) * 2 + 1];
  const int c16 = lane & 15, q4 = lane >> 4;
  bf16x8 cfr[4];
  {
    const float* cre = p.in[16] + ((size_t)(l * 32 + g) * 16 + c16) * 64;
    const float* cim = p.in[17] + ((size_t)(l * 32 + g) * 16 + c16) * 64;
#pragma unroll
    for (int ks = 0; ks < 4; ++ks) {
      float v[8];
#pragma unroll
      for (int jj = 0; jj < 8; ++jj) {
        int pp = 16 * ks + 4 * q4 + (jj >> 1);
        v[jj] = (jj & 1) ? -cim[pp] : cre[pp];
      }
      cfr[ks] = pack_frag(v[0], v[1], v[2], v[3], v[4], v[5], v[6], v[7]);
    }
  }
  uint4* fragL = (uint4*)(smem + 34816) + wave * 512;
  __syncthreads();
#pragma unroll
  for (int j = 0; j < 4; ++j) { fragL[j * 64 + lane] = __builtin_bit_cast(uint4, bfr[j]); fragL[(4 + j) * 64 + lane] = __builtin_bit_cast(uint4, cfr[j]); }
  const float dcoef = p.in[18][(l * 32 + g) * 16 + c16];
  const int hb_row = (r >> 2) & 1, trow = (r & 3) + 4 * (r >> 3);
  const bf16_t* U = (const bf16_t*)(ws + OFF_S5U);
  bf16_t* Y = (bf16_t*)(ws + OFF_S5Y);
  const bf16_t* up = U + ((size_t)(2 * bp + hb_row) * 4096 + trow) * 512 + g * 16 + hq * 8;
  float x0r = 0.f, x0i = 0.f, x1r = 0.f, x1i = 0.f;
  __syncthreads();
  const bf16_t* udp = U + ((size_t)(2 * bp) * 4096 + 4 * q4) * 512 + g * 16 + c16;
  uint4 uaA = *(const uint4*)up, uaB = *(const uint4*)(up + (size_t)16 * 512);
  typedef unsigned short us2_t __attribute__((ext_vector_type(2)));
  us2_t udA[2][2], udB[2][2];
#pragma unroll
  for (int hb2 = 0; hb2 < 2; ++hb2)
#pragma unroll
    for (int i2 = 0; i2 < 2; ++i2) {
      udA[hb2][i2].x = udp[((size_t)hb2 * 4096 + 2 * i2) * 512];
      udA[hb2][i2].y = udp[((size_t)hb2 * 4096 + 2 * i2 + 1) * 512];
      udB[hb2][i2].x = udp[((size_t)hb2 * 4096 + 16 + 2 * i2) * 512];
      udB[hb2][i2].y = udp[((size_t)hb2 * 4096 + 16 + 2 * i2 + 1) * 512];
    }
  auto step = [&](int it, uint4& ua, us2_t (&ud)[2][2]) __attribute__((always_inline)) {
    const int t0 = it * 16;
    f32x16 z;
#pragma unroll
    for (int i = 0; i < 16; ++i) z[i] = 0.f;
    bf16x8 uaf = u4_to_frag(ua);
    us2_t du[2][2];
#pragma unroll
    for (int hb2 = 0; hb2 < 2; ++hb2)
#pragma unroll
      for (int i2 = 0; i2 < 2; ++i2) du[hb2][i2] = ud[hb2][i2];
    {
      const int tn = min(it + 2, 255) * 16;
      ua = *(const uint4*)(up + (size_t)tn * 512);
#pragma unroll
      for (int hb2 = 0; hb2 < 2; ++hb2)
#pragma unroll
        for (int i2 = 0; i2 < 2; ++i2) {
          ud[hb2][i2].x = udp[((size_t)hb2 * 4096 + tn + 2 * i2) * 512];
          ud[hb2][i2].y = udp[((size_t)hb2 * 4096 + tn + 2 * i2 + 1) * 512];
        }
    }
    f32x16 bu0 = mfma32(uaf, u4_to_frag(fragL[0 * 64 + lane]), z), bu1 = mfma32(uaf, u4_to_frag(fragL[1 * 64 + lane]), z);
    f32x16 bu2 = mfma32(uaf, u4_to_frag(fragL[2 * 64 + lane]), z), bu3 = mfma32(uaf, u4_to_frag(fragL[3 * 64 + lane]), z);
#pragma unroll
    for (int i = 0; i < 16; ++i) {
      float nr = a0r * x0r - a0i * x0i + bu0[i];
      float ni = a0r * x0i + a0i * x0r + bu1[i];
      x0r = nr; x0i = ni;
      nr = a1r * x1r - a1i * x1i + bu2[i];
      ni = a1r * x1i + a1i * x1r + bu3[i];
      x1r = nr; x1i = ni;
      Xl[(hq * 16 + i) * 68 + r] = pk2(x0r, x0i);
      Xl[(hq * 16 + i) * 68 + 32 + r] = pk2(x1r, x1i);
    }
    __syncthreads();
#pragma unroll
    for (int hb2 = 0; hb2 < 2; ++hb2) {
      f32x4 y = {0.f, 0.f, 0.f, 0.f};
#pragma unroll
      for (int ks = 0; ks < 4; ++ks) {
        bf16x8 a = *(const bf16x8*)&Xl[(hb2 * 16 + c16) * 68 + 16 * ks + 4 * q4];
        y = mfma16(a, u4_to_frag(fragL[(4 + ks) * 64 + lane]), y);
      }
#pragma unroll
      for (int i2 = 0; i2 < 4; ++i2) {
        size_t tok = (size_t)(2 * bp + hb2) * 4096 + t0 + 4 * q4 + i2;
        float yy = y[i2] + dcoef * bf2f((i2 & 1) ? du[hb2][i2 >> 1].y : du[hb2][i2 >> 1].x);
        Y[tok * 512 + g * 16 + c16] = f2bf(geluf_(yy));
      }
    }
    __syncthreads();
  };
  __builtin_amdgcn_s_setprio(2);
  for (int it = 0; it < 256; it += 2) {
    step(it, uaA, udA);
    step(it + 1, uaB, udB);
  }
  __builtin_amdgcn_s_setprio(0);
}

__device__ __forceinline__ void glu_tile(const Params& p, int l, int tile, char* smem) {
  char* ws = p.ws;
  const int m0 = (tile >> 2) * 128, n0 = (tile & 3) * 128;
  const bf16_t* Yb = (const bf16_t*)(ws + OFF_S5Y);
  const bf16_t* A = Yb + (size_t)m0 * 512;
  const bf16_t* B = (const bf16_t*)(ws + OFF_WT_GLU(l)) + (size_t)n0 * 512;
  f32x16 acc[2][2];
  zero_acc<2>(acc);
  gemm_loop<2>([=](int row, int k) __attribute__((always_inline)) { return *(const uint4*)(A + (uint32_t)(row * 512 + k)); },
            [=](int row, int k) __attribute__((always_inline)) { return *(const uint4*)(B + (uint32_t)(row * 512 + k)); }, 512, acc, smem);
  bf16_t* G = (bf16_t*)(ws + OFF_GATES);
  const float* gb = p.in[21] + l * 512;
  {
    const int lane = otid() & 63, wave = otid() >> 6;
    const int wm = wave >> 1, wn = wave & 1, r = lane & 31, h = lane >> 5;
    const float gb0 = gb[n0 + wn * 64 + r], gb1 = gb[n0 + wn * 64 + 32 + r];
#pragma unroll 1
    for (int mt = 0; mt < 2; ++mt) {
      float yv[2][16], gv[2][16];
#pragma unroll
      for (int nt = 0; nt < 2; ++nt)
#pragma unroll
        for (int i = 0; i < 16; ++i) {
          uint32_t row = m0 + wm * 64 + mt * 32 + (i & 3) + 8 * (i >> 2) + 4 * h;
          uint32_t col = n0 + wn * 64 + nt * 32 + r;
          yv[nt][i] = bf2f(Yb[row * 512u + col]);
          gv[nt][i] = bf2f(G[(size_t)row * 1536 + 512 + col]);
        }
#pragma unroll
      for (int nt = 0; nt < 2; ++nt)
#pragma unroll
        for (int i = 0; i < 16; ++i) {
          uint32_t row = m0 + wm * 64 + mt * 32 + (i & 3) + 8 * (i >> 2) + 4 * h;
          uint32_t col = n0 + wn * 64 + nt * 32 + r;
          float a_ = mt ? acc[1][nt][i] : acc[0][nt][i];
          float z = a_ + (nt ? gb1 : gb0);
          G[(size_t)row * 1536 + 512 + col] = f2bf(yv[nt][i] * sigmoidf_(z) * gv[nt][i]);
        }
    }
  }
}

struct RwPre { bf16_t R[5], K[5], V[5], W[4], A[4]; float N[4]; };
__device__ __forceinline__ void rw_prefetch(RwPre& q, const bf16_t* MX, const bf16_t* WL, const bf16_t* AAp, const float* KNp, size_t tokb, int ts0, int cr) {
#pragma unroll
  for (int i = 0; i < 5; ++i) {
    int ts = ts0 - 1 + i;
    const bf16_t* b = MX + (tokb + (ts < 0 ? 0 : ts)) * 1664;
    bf16_t r_ = b[cr], k_ = b[512 + cr], v_ = b[1024 + cr];
    q.R[i] = ts < 0 ? (bf16_t)0 : r_; q.K[i] = ts < 0 ? (bf16_t)0 : k_; q.V[i] = ts < 0 ? (bf16_t)0 : v_;
  }
#pragma unroll
  for (int i = 0; i < 4; ++i) {
    q.W[i] = WL[(tokb + ts0 + i) * 512 + cr];
    q.A[i] = AAp[(tokb + ts0 + i) * 512 + cr];
    q.N[i] = KNp[(tokb + ts0 + i) * 8];
  }
}
__device__ __forceinline__ void rwkv_rec(const Params& p, int l, int task, char* smem) {
  char* ws = p.ws;
  float* sbuf = (float*)smem;
  const int tid = otid(), lane = tid & 63, wave = tid >> 6;
  const int bh = task >> 2, qr = task & 3, b = bh >> 3, hh = bh & 7;
  const int sub = lane & 15, vrow = qr * 16 + wave * 4 + (lane >> 4);
  const int cr = hh * 64 + lane;
  const float mur = p.in[22][l * 1664 + cr], muk = p.in[22][l * 1664 + 512 + cr], muv = p.in[22][l * 1664 + 1024 + cr];
  const float kkw = p.in[27][l * 512 + cr], kaw = p.in[28][l * 512 + cr];
  const size_t tokb = (size_t)b * 4096;
  const bf16_t* MX = (const bf16_t*)(ws + OFF_MIX);
  const bf16_t* WL = (const bf16_t*)(ws + OFF_WLOG);
  const bf16_t* AAp = (const bf16_t*)(ws + OFF_AA);
  bf16_t* YR = (bf16_t*)(ws + OFF_YRAW);
  const float* KNp = (const float*)(ws + OFF_KNORM) + hh;
  float S0 = 0.f, S1 = 0.f, S2 = 0.f, S3 = 0.f;
  RwPre qa, qb;
  rw_prefetch(qa, MX, WL, AAp, KNp, tokb, wave * 4, cr);
  rw_prefetch(qb, MX, WL, AAp, KNp, tokb, 16 + wave * 4, cr);
  __syncthreads();
  auto chunk = [&](int c, RwPre& q) __attribute__((always_inline)) {
    float* dst = sbuf + (c & 1) * 6144;
#pragma unroll
    for (int i = 0; i < 4; ++i) {
      int tl = wave * 4 + i;
      float rc = bf2f(q.R[i + 1]), rp = bf2f(q.R[i]);
      float kc = bf2f(q.K[i + 1]), kp_ = bf2f(q.K[i]);
      float vc = bf2f(q.V[i + 1]), vp = bf2f(q.V[i]);
      float rv = rc + (rp - rc) * mur, kv = kc + (kp_ - kc) * muk, vv = vc + (vp - vc) * muv;
      float dec = __expf(bf2f(q.W[i]));
      float a = bf2f(q.A[i]);
      float kkn = kv * kkw * q.N[i];
      float kpr = kv * (1.f + (a - 1.f) * kaw);
      dst[0 * 1024 + tl * 64 + lane] = rv;
      dst[1 * 1024 + tl * 64 + lane] = dec;
      dst[2 * 1024 + tl * 64 + lane] = kpr;
      dst[3 * 1024 + tl * 64 + lane] = vv;
      dst[4 * 1024 + tl * 64 + lane] = -kkn;
      dst[5 * 1024 + tl * 64 + lane] = kkn * a;
    }
    __syncthreads();
    rw_prefetch(q, MX, WL, AAp, KNp, tokb, min(c + 2, 255) * 16 + wave * 4, cr);
    float ykeep = 0.f;
#pragma unroll 4
    for (int tt = 0; tt < 16; ++tt) {
      const float4 r4 = *(const float4*)&dst[0 * 1024 + tt * 64 + sub * 4];
      const float4 w4 = *(const float4*)&dst[1 * 1024 + tt * 64 + sub * 4];
      const float4 k4 = *(const float4*)&dst[2 * 1024 + tt * 64 + sub * 4];
      const float vv = dst[3 * 1024 + tt * 64 + vrow];
      const float4 a4 = *(const float4*)&dst[4 * 1024 + tt * 64 + sub * 4];
      const float4 b4 = *(const float4*)&dst[5 * 1024 + tt * 64 + sub * 4];
      float sa = (S0 * a4.x + S1 * a4.y) + (S2 * a4.z + S3 * a4.w);
      sa = rr16(sa);
      S0 = S0 * w4.x + (sa * b4.x + vv * k4.x);
      S1 = S1 * w4.y + (sa * b4.y + vv * k4.y);
      S2 = S2 * w4.z + (sa * b4.z + vv * k4.z);
      S3 = S3 * w4.w + (sa * b4.w + vv * k4.w);
      float y = (S0 * r4.x + S1 * r4.y) + (S2 * r4.z + S3 * r4.w);
      y = rr16(y);
      ykeep = (sub == tt) ? y : ykeep;
    }
    YR[(tokb + c * 16 + sub) * 512 + hh * 64 + vrow] = f2bf(ykeep);
  };
  __builtin_amdgcn_s_setprio(3);
  for (int c = 0; c < 256; c += 2) {
    chunk(c, qa);
    chunk(c + 1, qb);
  }
  __builtin_amdgcn_s_setprio(0);
}

__device__ __forceinline__ void rwkv_knorm(const Params& p, int l, int task) {
  char* ws = p.ws;
  const int lane = otid() & 63, wave = otid() >> 6;
  const bf16_t* MX = (const bf16_t*)(ws + OFF_MIX);
  float* KN = (float*)(ws + OFF_KNORM);
  const int c0 = lane * 8;
  float muk[8], kkw[8];
  {
    float4 a = *(const float4*)(p.in[22] + l * 1664 + 512 + c0), b = *(const float4*)(p.in[22] + l * 1664 + 512 + c0 + 4);
    muk[0] = a.x; muk[1] = a.y; muk[2] = a.z; muk[3] = a.w; muk[4] = b.x; muk[5] = b.y; muk[6] = b.z; muk[7] = b.w;
    a = *(const float4*)(p.in[27] + l * 512 + c0); b = *(const float4*)(p.in[27] + l * 512 + c0 + 4);
    kkw[0] = a.x; kkw[1] = a.y; kkw[2] = a.z; kkw[3] = a.w; kkw[4] = b.x; kkw[5] = b.y; kkw[6] = b.z; kkw[7] = b.w;
  }
  uint4 kc4[8], kp4[8];
#pragma unroll
  for (int it = 0; it < 8; ++it) {
    const int tok = task * 32 + wave * 8 + it;
    const bool first = (tok & 4095) == 0;
    kc4[it] = *(const uint4*)(MX + (size_t)tok * 1664 + 512 + c0);
    kp4[it] = *(const uint4*)(MX + (size_t)(first ? tok : tok - 1) * 1664 + 512 + c0);
  }
#pragma unroll
  for (int it = 0; it < 8; ++it) {
    const int tok = task * 32 + wave * 8 + it;
    const bool first = (tok & 4095) == 0;
    float kc[8], kp[8];
    kc[0] = lo_bf(kc4[it].x); kc[1] = hi_bf(kc4[it].x); kc[2] = lo_bf(kc4[it].y); kc[3] = hi_bf(kc4[it].y);
    kc[4] = lo_bf(kc4[it].z); kc[5] = hi_bf(kc4[it].z); kc[6] = lo_bf(kc4[it].w); kc[7] = hi_bf(kc4[it].w);
    kp[0] = lo_bf(kp4[it].x); kp[1] = hi_bf(kp4[it].x); kp[2] = lo_bf(kp4[it].y); kp[3] = hi_bf(kp4[it].y);
    kp[4] = lo_bf(kp4[it].z); kp[5] = hi_bf(kp4[it].z); kp[6] = lo_bf(kp4[it].w); kp[7] = hi_bf(kp4[it].w);
    float ss = 0.f;
#pragma unroll
    for (int i = 0; i < 8; ++i) {
      float pk = first ? 0.f : kp[i];
      float kq = (kc[i] + (pk - kc[i]) * muk[i]) * kkw[i];
      ss += kq * kq;
    }
    ss = rr8(ss);
    if ((lane & 7) == 0) KN[(size_t)tok * 8 + (lane >> 3)] = 1.f / fmaxf(sqrtf(ss), 1e-12f);
  }
}

__device__ __forceinline__ void unpack8(uint4 v, float (&f)[8]) {
  f[0] = lo_bf(v.x); f[1] = hi_bf(v.x); f[2] = lo_bf(v.y); f[3] = hi_bf(v.y);
  f[4] = lo_bf(v.z); f[5] = hi_bf(v.z); f[6] = lo_bf(v.w); f[7] = hi_bf(v.w);
}
__device__ __forceinline__ void load8f(const float* p, float (&f)[8]) {
  float4 a = *(const float4*)p, b = *(const float4*)(p + 4);
  f[0] = a.x; f[1] = a.y; f[2] = a.z; f[3] = a.w; f[4] = b.x; f[5] = b.y; f[6] = b.z; f[7] = b.w;
}
__device__ __forceinline__ void rwkv_post(const Params& p, int l, int task) {
  char* ws = p.ws;
  const int lane = otid() & 63, wave = otid() >> 6;
  const bf16_t* MX = (const bf16_t*)(ws + OFF_MIX);
  const bf16_t* AAp = (const bf16_t*)(ws + OFF_AA);
  const bf16_t* YR = (const bf16_t*)(ws + OFF_YRAW);
  bf16_t* G = (bf16_t*)(ws + OFF_GATES);
  const int c0 = lane * 8;
  float lnw[8], lnb[8], mur[8], muk[8], muv[8], ka[8], rk[8];
  load8f(p.in[30] + l * 512 + c0, lnw);
  load8f(p.in[31] + l * 512 + c0, lnb);
  load8f(p.in[22] + l * 1664 + c0, mur);
  load8f(p.in[22] + l * 1664 + 512 + c0, muk);
  load8f(p.in[22] + l * 1664 + 1024 + c0, muv);
  load8f(p.in[28] + l * 512 + c0, ka);
  load8f(p.in[29] + l * 512 + c0, rk);
#pragma unroll 1
  for (int it = 0; it < 8; it += 2) {
    uint4 y4[2], rc4[2], kc4[2], vc4[2], rp4[2], kp4[2], vp4[2], a4[2], g4[2];
#pragma unroll
    for (int u = 0; u < 2; ++u) {
      const int tok = task * 32 + wave * 8 + it + u;
      const bool first = (tok & 4095) == 0;
      const bf16_t* cur = MX + (size_t)tok * 1664 + c0;
      const bf16_t* prv = MX + (size_t)(first ? tok : tok - 1) * 1664 + c0;
      y4[u] = *(const uint4*)(YR + (size_t)tok * 512 + c0);
      rc4[u] = *(const uint4*)(cur); kc4[u] = *(const uint4*)(cur + 512); vc4[u] = *(const uint4*)(cur + 1024);
      rp4[u] = *(const uint4*)(prv); kp4[u] = *(const uint4*)(prv + 512); vp4[u] = *(const uint4*)(prv + 1024);
      a4[u] = *(const uint4*)(AAp + (size_t)tok * 512 + c0);
      g4[u] = *(const uint4*)(G + (size_t)tok * 1536 + 1024 + c0);
    }
#pragma unroll
    for (int u = 0; u < 2; ++u) {
      const int tok = task * 32 + wave * 8 + it + u;
      const bool first = (tok & 4095) == 0;
      float y[8], rc[8], kc[8], vc[8], rp[8], kp[8], vp[8], a[8], g[8];
      unpack8(y4[u], y); unpack8(rc4[u], rc); unpack8(kc4[u], kc); unpack8(vc4[u], vc);
      unpack8(rp4[u], rp); unpack8(kp4[u], kp); unpack8(vp4[u], vp); unpack8(a4[u], a); unpack8(g4[u], g);
      float sm = 0.f;
#pragma unroll
      for (int i = 0; i < 8; ++i) sm += y[i];
      const float mean = rr8(sm) * (1.f / 64.f);
      float sq = 0.f;
#pragma unroll
      for (int i = 0; i < 8; ++i) { y[i] -= mean; sq += y[i] * y[i]; }
      const float rs = rsqrtf(rr8(sq) * (1.f / 64.f) + 64e-5f);
      float bs = 0.f, vv[8];
#pragma unroll
      for (int i = 0; i < 8; ++i) {
        float pr = first ? 0.f : rp[i], pk = first ? 0.f : kp[i], pv = first ? 0.f : vp[i];
        float rv = rc[i] + (pr - rc[i]) * mur[i];
        float kv = kc[i] + (pk - kc[i]) * muk[i];
        vv[i] = vc[i] + (pv - vc[i]) * muv[i];
        float kpr = kv * (1.f + (a[i] - 1.f) * ka[i]);
        bs += rv * kpr * rk[i];
      }
      bs = rr8(bs);
      float o[8];
#pragma unroll
      for (int i = 0; i < 8; ++i) o[i] = (y[i] * rs * lnw[i] + lnb[i] + bs * vv[i]) * g[i];
      uint4 ov; ov.x = pk2(o[0], o[1]); ov.y = pk2(o[2], o[3]); ov.z = pk2(o[4], o[5]); ov.w = pk2(o[6], o[7]);
      *(uint4*)(G + (size_t)tok * 1536 + 1024 + c0) = ov;
    }
  }
}

template <int MODE, bool EDGE>
__device__ __forceinline__ void nsa_half(int kt, int half, const bf16x8 (&qf)[4], int t, bool bsel, float& m, float& lsum,
                                         f32x16& o0, f32x16& o1, const bf16_t* Ks, const bf16_t* Vt, int r, int h) {
  f32x16 s;
#pragma unroll
  for (int i = 0; i < 16; ++i) s[i] = 0.f;
#pragma unroll
  for (int sp = 0; sp < 4; ++sp) {
    bf16x8 a = *(const bf16x8*)&Ks[(half * 32 + r) * 72 + sp * 16 + h * 8];
    s = mfma32(a, qf[sp], s);
  }
  if (EDGE) {
#pragma unroll
    for (int i = 0; i < 16; ++i) {
      int key = kt * 64 + half * 32 + (i & 3) + 8 * (i >> 2) + 4 * h;
      bool v = (key <= t) && (MODE == 0 || key > t - 512);
      s[i] = v ? s[i] : -1e30f;
    }
  }
  float tmax = s[0];
#pragma unroll
  for (int i = 1; i < 16; ++i) tmax = fmaxf(tmax, s[i]);
  tmax = bsel ? tmax : -1e30f;
  tmax = fmaxf(tmax, __shfl_xor(tmax, 32));
  const float mn = fmaxf(m, tmax);
  const bool same = (mn == m);
  const float alpha = ex2(m - mn);
  m = mn;
  const float mb = bsel ? mn : 3e38f;
  float pv[16], ps = 0.f;
#pragma unroll
  for (int i = 0; i < 16; ++i) {
    float e = ex2(s[i] - mb);
    if (EDGE) e = (s[i] > -1e29f) ? e : 0.f;
    pv[i] = e;
    ps += e;
  }
  lsum = lsum * alpha + ps;
  if (!__all(same)) {
#pragma unroll
    for (int i = 0; i < 16; ++i) { o0[i] *= alpha; o1[i] *= alpha; }
  }
  bf16x8 pf0 = pack_frag(pv[0], pv[1], pv[2], pv[3], pv[4], pv[5], pv[6], pv[7]);
  bf16x8 pf1 = pack_frag(pv[8], pv[9], pv[10], pv[11], pv[12], pv[13], pv[14], pv[15]);
#pragma unroll
  for (int sidx = 0; sidx < 2; ++sidx) {
    uint2 l0 = *(const uint2*)&Vt[r * 72 + half * 32 + sidx * 16 + 4 * h];
    uint2 l1 = *(const uint2*)&Vt[r * 72 + half * 32 + sidx * 16 + 8 + 4 * h];
    uint2 l2 = *(const uint2*)&Vt[(32 + r) * 72 + half * 32 + sidx * 16 + 4 * h];
    uint2 l3 = *(const uint2*)&Vt[(32 + r) * 72 + half * 32 + sidx * 16 + 8 + 4 * h];
    bf16x8 va0 = u4_to_frag(make_uint4(l0.x, l0.y, l1.x, l1.y));
    bf16x8 va1 = u4_to_frag(make_uint4(l2.x, l2.y, l3.x, l3.y));
    o0 = mfma32(va0, sidx ? pf1 : pf0, o0);
    o1 = mfma32(va1, sidx ? pf1 : pf0, o1);
  }
}

template <int MODE>
__device__ __forceinline__ void nsa_sweep(const bf16_t* Kb, const bf16_t* Vtb, int tile_lo, int tile_hi, const bf16x8 (&qf)[4],
                                          int t, int t0, unsigned long long selmask, f32x16& o0, f32x16& o1, float& lout, bf16_t* Ks0) {
  const int tid = otid(), lane = tid & 63, r = lane & 31, h = lane >> 5;
  float m = -1e30f, lsum = 0.f;
#pragma unroll
  for (int i = 0; i < 16; ++i) { o0[i] = 0.f; o1[i] = 0.f; }
  const int row0_ = tid >> 3, kc0_ = tid & 7, row1_ = (tid + 256) >> 3;
  uint4 pk0, pk1, pv0, pv1;
#define KVLOAD(KT) { const int kt__ = (KT); \
    pk0 = *(const uint4*)(Kb + (size_t)(kt__ * 64 + row0_) * 64 + kc0_ * 8); \
    pk1 = *(const uint4*)(Kb + (size_t)(kt__ * 64 + row1_) * 64 + kc0_ * 8); \
    pv0 = *(const uint4*)(Vtb + (size_t)row0_ * 4096 + kt__ * 64 + kc0_ * 8); \
    pv1 = *(const uint4*)(Vtb + (size_t)row1_ * 4096 + kt__ * 64 + kc0_ * 8); }
#define KVWRITE(BUF) { bf16_t* d__ = Ks0 + (BUF) * (128 * 72); \
    *(uint4*)&d__[row0_ * 72 + kc0_ * 8] = pk0; \
    *(uint4*)&d__[row1_ * 72 + kc0_ * 8] = pk1; \
    *(uint4*)&d__[64 * 72 + row0_ * 72 + kc0_ * 8] = pv0; \
    *(uint4*)&d__[64 * 72 + row1_ * 72 + kc0_ * 8] = pv1; }
  KVLOAD(tile_lo);
  __syncthreads();
  KVWRITE(0);
  __syncthreads();
  for (int kt = tile_lo; kt <= tile_hi; ++kt) {
    const int cur = (kt - tile_lo) & 1;
    const bf16_t* Ks = Ks0 + cur * (128 * 72);
    const bf16_t* Vt = Ks + 64 * 72;
    KVLOAD(min(kt + 1, tile_hi));
    const bool bsel = (MODE == 0) ? (((selmask >> kt) & 1ull) != 0) : true;
    const bool interior = (kt * 64 + 63 <= t0) && (MODE == 0 || kt * 64 > t0 + 31 - 512);
    if (interior) {
#pragma unroll 1
      for (int half = 0; half < 2; ++half) nsa_half<MODE, false>(kt, half, qf, t, bsel, m, lsum, o0, o1, Ks, Vt, r, h);
    } else {
#pragma unroll 1
      for (int half = 0; half < 2; ++half) nsa_half<MODE, true>(kt, half, qf, t, bsel, m, lsum, o0, o1, Ks, Vt, r, h);
    }
    KVWRITE(cur ^ 1);
    __syncthreads();
  }
  lout = lsum + __shfl_xor(lsum, 32);
}

__device__ __forceinline__ void nsa_tile(const Params& p, int l, int task, char* smem) {
  char* ws = p.ws;
  bf16_t* Ks = (bf16_t*)smem;
  bf16_t* Vt = Ks + 64 * 72;
  float* impL = (float*)(smem + 4 * 64 * 72 * 2);
  float* impS = impL + 4 * 32 * 65;
  unsigned char* selB = (unsigned char*)(impS + 32 * 65);
  const int tid = otid(), lane = tid & 63, wave = tid >> 6, r = lane & 31, h = lane >> 5;
  const int bg = task & 15, tt = 127 - (task >> 4);
  const int b = bg >> 1, g = bg & 1;
  const int t0 = tt * 32, t = t0 + r, blk_t = t0 >> 6;
  const int head = g * 4 + wave;
  const size_t tok = (size_t)b * 4096 + t;
  bf16x8 qf[4];
  {
    const bf16_t* Qp = (const bf16_t*)(ws + OFF_Q) + tok * 512 + head * 64 + h * 8;
#pragma unroll
    for (int sp = 0; sp < 4; ++sp) qf[sp] = *(const bf16x8*)(Qp + sp * 16);
  }
  const float* ng = (const float*)(ws + OFF_NSAG) + tok * 32 + head * 3;
  const float g0 = sigmoidf_(ng[0]), g1 = sigmoidf_(ng[1]), g2 = sigmoidf_(ng[2]);
  f32x16 oc0, oc1;
  float* outL = impL;
  const bf16_t* KCb = (const bf16_t*)(ws + OFF_KCMP) + (size_t)bg * 256 * 64;
  const bf16_t* VCb = (const bf16_t*)(ws + OFF_VCMPT) + (size_t)bg * 64 * 256;
  const int nct = (t0 >> 9) + 1;
  float m = -1e30f, lsum = 0.f;
  for (int ct = 0; ct < nct; ++ct) {
    __syncthreads();
    { int row = tid >> 3, kc = tid & 7; *(uint4*)&Ks[row * 72 + kc * 8] = *(const uint4*)(KCb + (size_t)(ct * 32 + row) * 64 + kc * 8); }
    __syncthreads();
    f32x16 s;
#pragma unroll
    for (int i = 0; i < 16; ++i) s[i] = 0.f;
#pragma unroll
    for (int sp = 0; sp < 4; ++sp) {
      bf16x8 a = *(const bf16x8*)&Ks[r * 72 + sp * 16 + h * 8];
      s = mfma32(a, qf[sp], s);
    }
    float tmax = -1e30f;
#pragma unroll
    for (int i = 0; i < 16; ++i) {
      int n = ct * 32 + (i & 3) + 8 * (i >> 2) + 4 * h;
      bool v = (16 * n + 31 <= t);
      tmax = fmaxf(tmax, v ? s[i] : -1e30f);
    }
    float mn = fmaxf(m, tmax), ps = 0.f;
#pragma unroll
    for (int i = 0; i < 16; ++i) {
      int n = ct * 32 + (i & 3) + 8 * (i >> 2) + 4 * h;
      bool v = (16 * n + 31 <= t);
      ps += v ? ex2(s[i] - mn) : 0.f;
    }
    lsum = lsum * ex2(m - mn) + ps;
    m = mn;
  }
  {
    float mo = __shfl_xor(m, 32), lo = __shfl_xor(lsum, 32);
    float mt_ = fmaxf(m, mo);
    float lt = lsum * ex2(m - mt_) + lo * ex2(mo - mt_);
    m = mt_;
    lsum = lt > 0.f ? 1.f / lt : 0.f;
  }
  {
#pragma unroll
    for (int i = 0; i < 16; ++i) { oc0[i] = 0.f; oc1[i] = 0.f; }
    float carry = 0.f;
    for (int ct = 0; ct < nct; ++ct) {
      __syncthreads();
      { int row = tid >> 3, kc = tid & 7; *(uint4*)&Ks[row * 72 + kc * 8] = *(const uint4*)(KCb + (size_t)(ct * 32 + row) * 64 + kc * 8); }
      { int row = tid >> 2, kc = tid & 3; *(uint4*)&Vt[row * 72 + kc * 8] = *(const uint4*)(VCb + (size_t)row * 256 + ct * 32 + kc * 8); }
      __syncthreads();
      f32x16 s;
#pragma unroll
      for (int i = 0; i < 16; ++i) s[i] = 0.f;
#pragma unroll
      for (int sp = 0; sp < 4; ++sp) {
        bf16x8 a = *(const bf16x8*)&Ks[r * 72 + sp * 16 + h * 8];
        s = mfma32(a, qf[sp], s);
      }
      float pv[16];
#pragma unroll
      for (int i = 0; i < 16; ++i) {
        int n = ct * 32 + (i & 3) + 8 * (i >> 2) + 4 * h;
        bool v = (16 * n + 31 <= t);
        pv[i] = v ? ex2(s[i] - m) * lsum : 0.f;
      }
      bf16x8 pf0 = pack_frag(pv[0], pv[1], pv[2], pv[3], pv[4], pv[5], pv[6], pv[7]);
      bf16x8 pf1 = pack_frag(pv[8], pv[9], pv[10], pv[11], pv[12], pv[13], pv[14], pv[15]);
#pragma unroll
      for (int sidx = 0; sidx < 2; ++sidx) {
        uint2 l0 = *(const uint2*)&Vt[r * 72 + sidx * 16 + 4 * h];
        uint2 l1 = *(const uint2*)&Vt[r * 72 + sidx * 16 + 8 + 4 * h];
        uint2 l2 = *(const uint2*)&Vt[(32 + r) * 72 + sidx * 16 + 4 * h];
        uint2 l3 = *(const uint2*)&Vt[(32 + r) * 72 + sidx * 16 + 8 + 4 * h];
        bf16x8 va0 = u4_to_frag(make_uint4(l0.x, l0.y, l1.x, l1.y));
        bf16x8 va1 = u4_to_frag(make_uint4(l2.x, l2.y, l3.x, l3.y));
        oc0 = mfma32(va0, sidx ? pf1 : pf0, oc0);
        oc1 = mfma32(va1, sidx ? pf1 : pf0, oc1);
      }
#pragma unroll
      for (int qd = 0; qd < 4; ++qd) {
        float A_ = pv[4 * qd] + pv[4 * qd + 1] + pv[4 * qd + 2] + 0.5f * pv[4 * qd + 3];
        float B_ = 0.5f * pv[4 * qd + 3];
        float recv = __shfl_xor(B_, 32);
        float val = A_ + (h ? recv : carry);
        carry = recv;
        impL[(wave * 32 + r) * 65 + 8 * ct + 2 * qd + h] = val;
      }
    }
  }
  __syncthreads();
  {
    const int tk = tid >> 3, mg = tid & 7;
#pragma unroll
    for (int j = 0; j < 8; ++j) {
      int m_ = mg * 8 + j;
      float v = 0.f;
      if (m_ <= blk_t) v = (impL[(0 * 32 + tk) * 65 + m_] + impL[(1 * 32 + tk) * 65 + m_]) + (impL[(2 * 32 + tk) * 65 + m_] + impL[(3 * 32 + tk) * 65 + m_]);
      impS[tk * 65 + m_] = v;
    }
    __syncthreads();
    unsigned bits = 0;
#pragma unroll
    for (int j = 0; j < 8; ++j) {
      int m_ = mg * 8 + j;
      bool sel;
      if (m_ > blk_t) sel = false;
      else if (m_ == 0 || m_ == blk_t || blk_t < 16) sel = true;
      else {
        float v = impS[tk * 65 + m_];
        int cnt = 0;
        for (int m2 = 1; m2 < blk_t; ++m2) {
          float v2 = impS[tk * 65 + m2];
          cnt += ((v2 > v) || (v2 == v && m2 < m_)) ? 1 : 0;
        }
        sel = cnt < 14;
      }
      bits |= (sel ? 1u : 0u) << j;
    }
    selB[tk * 8 + mg] = (unsigned char)bits;
  }
  __syncthreads();
  const unsigned long long selmask = *(const unsigned long long*)&selB[r * 8];
#pragma unroll
  for (int i = 0; i < 16; ++i) { outL[i * 256 + tid] = g0 * oc0[i]; outL[(16 + i) * 256 + tid] = g0 * oc1[i]; }
  {
    f32x16 o0, o1; float ls;
    nsa_sweep<0>((const bf16_t*)(ws + OFF_KS) + (size_t)bg * 4096 * 64, (const bf16_t*)(ws + OFF_VST) + (size_t)bg * 64 * 4096,
                 0, blk_t, qf, t, t0, selmask, o0, o1, ls, Ks);
    float sc = g1 / ls;
#pragma unroll
    for (int i = 0; i < 16; ++i) { outL[i * 256 + tid] += sc * o0[i]; outL[(16 + i) * 256 + tid] += sc * o1[i]; }
  }
  {
    f32x16 o0, o1; float ls;
    int lo = t0 - 511; lo = lo < 0 ? 0 : lo;
    nsa_sweep<1>((const bf16_t*)(ws + OFF_KW) + (size_t)bg * 4096 * 64, (const bf16_t*)(ws + OFF_VWT) + (size_t)bg * 64 * 4096,
                 lo >> 6, blk_t, qf, t, t0, 0ull, o0, o1, ls, Ks);
    float sc = g2 / ls;
#pragma unroll
    for (int i = 0; i < 16; ++i) { oc0[i] = outL[i * 256 + tid] + sc * o0[i]; oc1[i] = outL[(16 + i) * 256 + tid] + sc * o1[i]; }
  }
  bf16_t* G = (bf16_t*)(ws + OFF_GATES) + tok * 1536 + head * 64;
  uint2 gva[4], gvb[4];
#pragma unroll
  for (int qd = 0; qd < 4; ++qd) {
    gva[qd] = *(const uint2*)(G + 8 * qd + 4 * h);
    gvb[qd] = *(const uint2*)(G + 32 + 8 * qd + 4 * h);
  }
#pragma unroll
  for (int qd = 0; qd < 4; ++qd) {
    int d0 = 8 * qd + 4 * h;
    uint2 ov;
    ov.x = pk2(oc0[4 * qd] * lo_bf(gva[qd].x), oc0[4 * qd + 1] * hi_bf(gva[qd].x));
    ov.y = pk2(oc0[4 * qd + 2] * lo_bf(gva[qd].y), oc0[4 * qd + 3] * hi_bf(gva[qd].y));
    *(uint2*)(G + d0) = ov;
    ov.x = pk2(oc1[4 * qd] * lo_bf(gvb[qd].x), oc1[4 * qd + 1] * hi_bf(gvb[qd].x));
    ov.y = pk2(oc1[4 * qd + 2] * lo_bf(gvb[qd].y), oc1[4 * qd + 3] * hi_bf(gvb[qd].y));
    *(uint2*)(G + 32 + d0) = ov;
  }
}

__device__ __forceinline__ void merge_tile(const Params& p, int l, int tile, char* smem) {
  char* ws = p.ws;
  const int m0 = (tile >> 3) * 128, n0 = (tile & 7) * 128;
  const bf16_t* Hh = (const bf16_t*)(ws + OFF_H2) + (size_t)m0 * 1024;
  const bf16_t* Br = (const bf16_t*)(ws + OFF_GATES) + (size_t)m0 * 1536;
  uint32_t* sgL = (uint32_t*)(smem + 36864) + otid();
  f32x16 mg[2][2];
  zero_acc<2>(mg);
#pragma unroll 1
  for (int n = 0; n < 3; ++n) {
    f32x16 acc[2][2];
    zero_acc<2>(acc);
    const bf16_t* Bg = (const bf16_t*)(ws + OFF_WT_IN(l)) + (size_t)(5120 + n * 1024 + n0) * 1024;
    gemm_loop<2, true>([=](int row, int k) __attribute__((always_inline)) { return *(const uint4*)(Hh + (uint32_t)(row * 1024 + k)); },
                       [=](int row, int k) __attribute__((always_inline)) { return *(const uint4*)(Bg + (uint32_t)(row * 1024 + k)); }, 1024, acc, smem);
#pragma unroll
    for (int a = 0; a < 2; ++a)
#pragma unroll
      for (int b = 0; b < 2; ++b)
#pragma unroll
        for (int i = 0; i < 8; ++i) sgL[((a * 2 + b) * 8 + i) * 256] = pk2(sigmoidf_(acc[a][b][2 * i]), sigmoidf_(acc[a][b][2 * i + 1]));
    zero_acc<2>(acc);
    const bf16_t* Bu = (const bf16_t*)(ws + OFF_WT_UP(l)) + ((size_t)n * 1024 + n0) * 512;
    const bf16_t* Ab = Br + n * 512;
    gemm_loop<2, true>([=](int row, int k) __attribute__((always_inline)) { return *(const uint4*)(Ab + (uint32_t)(row * 1536 + k)); },
                       [=](int row, int k) __attribute__((always_inline)) { return *(const uint4*)(Bu + (uint32_t)(row * 512 + k)); }, 512, acc, smem);
#pragma unroll
    for (int a = 0; a < 2; ++a)
#pragma unroll
      for (int b = 0; b < 2; ++b)
#pragma unroll
        for (int i = 0; i < 8; ++i) {
          uint32_t sv = sgL[((a * 2 + b) * 8 + i) * 256];
          mg[a][b][2 * i] += lo_bf(sv) * acc[a][b][2 * i];
          mg[a][b][2 * i + 1] += hi_bf(sv) * acc[a][b][2 * i + 1];
        }
  }
  bf16_t* M = (bf16_t*)(ws + OFF_MERGED);
  gemm_epi(mg, m0, n0, [=](int row0, int col, float a0, float a1, float a2, float a3, float b0, float b1, float b2, float b3) __attribute__((always_inline)) {
    float av[4] = {a0, a1, a2, a3}, bv[4] = {b0, b1, b2, b3};
#pragma unroll
    for (int j = 0; j < 4; ++j) {
      M[(size_t)(row0 + j) * 1024 + col] = f2bf(av[j]);
      M[(size_t)(row0 + j) * 1024 + col + 32] = f2bf(bv[j]);
    }
  });
}

__device__ __forceinline__ void out_tile(const Params& p, int l, int tile, char* smem) {
  char* ws = p.ws;
  const int m0 = (tile >> 3) * 128, n0 = (tile & 7) * 128;
  const bf16_t* A = (const bf16_t*)(ws + OFF_MERGED) + (size_t)m0 * 1024;
  const bf16_t* B = (const bf16_t*)(ws + OFF_WT_OUT(l)) + (size_t)n0 * 1024;
  f32x16 acc[2][2];
  zero_acc<2>(acc);
  gemm_loop<2>([=](int row, int k) __attribute__((always_inline)) { return *(const uint4*)(A + (uint32_t)(row * 1024 + k)); },
            [=](int row, int k) __attribute__((always_inline)) { return *(const uint4*)(B + (uint32_t)(row * 1024 + k)); }, 1024, acc, smem);
  const float* xin = (l == 0) ? p.in[0] : p.out;
  float* xo = p.out;
  const float* md = (const float*)(ws + OFF_MOD) + (size_t)l * 8 * 3072 + 2048;
  {
    const int lane = otid() & 63, wave = otid() >> 6;
    const int wm = wave >> 1, wn = wave & 1, r = lane & 31, h = lane >> 5;
    const int b = m0 >> 12;
    const float g0 = md[b * 3072 + n0 + wn * 64 + r], g1 = md[b * 3072 + n0 + wn * 64 + 32 + r];
    float xv[2][2][16];
#pragma unroll
    for (int mt = 0; mt < 2; ++mt)
#pragma unroll
      for (int nt = 0; nt < 2; ++nt)
#pragma unroll
        for (int i = 0; i < 16; ++i) {
          int row = m0 + wm * 64 + mt * 32 + (i & 3) + 8 * (i >> 2) + 4 * h;
          xv[mt][nt][i] = xin[(size_t)row * 1024 + n0 + wn * 64 + nt * 32 + r];
        }
#pragma unroll
    for (int mt = 0; mt < 2; ++mt)
#pragma unroll
      for (int nt = 0; nt < 2; ++nt)
#pragma unroll
        for (int i = 0; i < 16; ++i) {
          int row = m0 + wm * 64 + mt * 32 + (i & 3) + 8 * (i >> 2) + 4 * h;
          xo[(size_t)row * 1024 + n0 + wn * 64 + nt * 32 + r] = xv[mt][nt][i] + (nt ? g1 : g0) * acc[mt][nt][i];
        }
  }
}

#define N_PHASES 18
#define OFF_CTR (499 * MIB)
__device__ __forceinline__ int next_tile(int* ctr, char* smem) {
  int* st = (int*)(smem + SMEM_BYTES - 16);
  __syncthreads();
  if (otid() == 0) *st = atomicAdd(ctr, 1);
  __syncthreads();
  return __builtin_amdgcn_readfirstlane(*st);
}
__device__ __forceinline__ unsigned xcc_id() { return (unsigned)__builtin_amdgcn_s_getreg((3 << 11) | 20) & 7u; }
__device__ __forceinline__ int next_tile_x(int* ctrs, int per_xcd, int xcd0, int& xq, char* smem) {
  int* st = (int*)(smem + SMEM_BYTES - 16);
  __syncthreads();
  if (otid() == 0) {
    int res = -1, q = xq;
    while (q < 8) {
      int x = (xcd0 + q) & 7;
      int i = atomicAdd(&ctrs[x], 1);
      if (i < per_xcd) { res = x * per_xcd + i; break; }
      ++q;
    }
    st[0] = res; st[1] = q;
  }
  __syncthreads();
  xq = __builtin_amdgcn_readfirstlane(st[1]);
  return __builtin_amdgcn_readfirstlane(st[0]);
}
__device__ __forceinline__ void run_phase(const Params& p, int ph, char* smem, int mask = 7) {
  const int vb = blockIdx.x, nvb = gridDim.x, wave = otid() >> 6;
  int* ctr = (int*)(p.ws + OFF_CTR) + ph;
  int* ctrx = (int*)(p.ws + OFF_CTR) + 32 + ph * 8;
  const int xcd0 = (int)xcc_id();
  int xq = 0;
  if (ph == 0) {
    for (int i = vb * 256 + otid(); i < 5120; i += nvb * 256) ((int*)(p.ws + OFF_CTR))[i] = 0;
    phase_prep(p, smem);
    return;
  }
  if (ph == 17) {
    for (int row = (vb * 4 + wave) * 4; row < NTOK; row += nvb * 16) final_norm_rows<4>(p, row);
    return;
  }
  const int l = (ph - 1) >> 3, sp = (ph - 1) & 7;
  switch (sp) {
    case 0:
      for (int row = (vb * 4 + wave) * 4; row < NTOK; row += nvb * 16) norm_rows<4>(p, l, row, (bf16_t*)(p.ws + OFF_H1));
      break;
    case 1:
      for (int t = next_tile_x(ctrx, 640, xcd0, xq, smem); t >= 0; t = next_tile_x(ctrx, 640, xcd0, xq, smem)) {
        int x = t / 640, i = t % 640;
        proj_tile(p, l, ((x >> 2) * 64 + i / 10) * 40 + (x & 3) * 10 + (i % 10), smem);
      }
      break;
    case 2:
      for (int t = next_tile(ctr, smem); t < 128 + 2048 + 1024; t = next_tile(ctr, smem)) {
        if (t < 128) cmp1_tile(p, l, t, smem);
        else if (t < 128 + 2048) lora_tile(p, l, t - 128, smem);
        else rwkv_knorm(p, l, t - 128 - 2048);
      }
      break;
    case 3:
      for (int t = next_tile(ctr, smem); t < 64; t = next_tile(ctr, smem)) cmp2_tile(p, l, t, smem);
      break;
    case 4:
    {
      int* st = (int*)(smem + SMEM_BYTES - 16);
      __syncthreads();
      if (otid() == 0) {
        unsigned key = (unsigned)xcd0 * 256u + (((unsigned)__builtin_amdgcn_s_getreg(63492) >> 8) & 0xffu);
        st[2] = atomicAdd((int*)(p.ws + OFF_CTR) + 1024 + l * 2048 + key, 1);
      }
      __syncthreads();
      const bool longrole = (st[2] == 0);
      int* ctr_s5 = (int*)(p.ws + OFF_CTR) + 200 + ph;
      for (int stage = 0; stage < 3; ++stage) {
        const int which = longrole ? stage : (stage + 1) % 3;
        if (which == 0) {
          if (mask & 1)
            for (int t = next_tile(ctr, smem); t < 256; t = next_tile(ctr, smem)) rwkv_rec(p, l, t, smem);
        } else if (which == 1) {
          if (mask & 2)
            for (int t = next_tile(ctr_s5, smem); t < 32; t = next_tile(ctr_s5, smem)) s5_scan(p, l, t, smem);
        } else {
          if (mask & 4)
            for (int t = next_tile_x(ctrx, 256, xcd0, xq, smem); t >= 0; t = next_tile_x(ctrx, 256, xcd0, xq, smem)) {
              int x = t >> 8, i = t & 255;
              nsa_tile(p, l, ((i >> 1) << 4) | (2 * x + (i & 1)), smem);
            }
        }
      }
      break;
    }
    case 5:
      for (int t = next_tile(ctr, smem); t < 1024 + 1024 + 1024; t = next_tile(ctr, smem)) {
        if (t < 1024) glu_tile(p, l, t, smem);
        else if (t < 2048) rwkv_post(p, l, t - 1024);
        else {
          int base = (t - 2048) * 32 + wave * 8;
          for (int i = 0; i < 8; i += 4) norm_rows<4>(p, l, base + i, (bf16_t*)(p.ws + OFF_H2));
        }
      }
      break;
    case 6:
      for (int t = next_tile_x(ctrx, 256, xcd0, xq, smem); t >= 0; t = next_tile_x(ctrx, 256, xcd0, xq, smem)) {
        int x = t >> 8, i = t & 255;
        merge_tile(p, l, ((x >> 2) * 128 + (i >> 1)) * 8 + (x & 3) * 2 + (i & 1), smem);
      }
      break;
    case 7:
      for (int t = next_tile_x(ctrx, 256, xcd0, xq, smem); t >= 0; t = next_tile_x(ctrx, 256, xcd0, xq, smem)) {
        int x = t >> 8, i = t & 255;
        out_tile(p, l, (32 * x + (i >> 3)) * 8 + (i & 7), smem);
      }
      break;
  }
}


#define XB_TMO      128
#define XB_XCNT(j)  (256  + 64 * (j))
#define XB_XSUB(j)  (1280 + 64 * (j))
#define XB_XGEN(j)  (2304 + 64 * (j))
#define XB_TOP      3328
#define XB_TOPGEN   3392
#define XCD_BAR_WORDS 3456
#define XB_SPIN_CAP (1u << 22)
#define LAS __attribute__((address_space(3)))
__device__ __forceinline__ unsigned xb_ld(unsigned* p)              { return __hip_atomic_load(p, __ATOMIC_RELAXED, __HIP_MEMORY_SCOPE_AGENT); }
__device__ __forceinline__ unsigned xb_add(unsigned* p, unsigned v) { return __hip_atomic_fetch_add(p, v, __ATOMIC_RELAXED, __HIP_MEMORY_SCOPE_AGENT); }
__device__ __forceinline__ unsigned xb_xcc_id() { return (unsigned)__builtin_amdgcn_s_getreg((3 << 11) | 20) & 0xFu; }
#define XB_SPIN(cond, bar) do { unsigned _sp = 0; while (cond) { __builtin_amdgcn_s_sleep(1); \
    if ((++_sp & 255u) == 0u) { if (xb_ld(&(bar)[XB_TMO])) break; if (_sp > XB_SPIN_CAP) { atomicAdd(&(bar)[XB_TMO], 1u); break; } } } } while (0)
struct XcdBarrier { unsigned* bar; unsigned x; volatile LAS unsigned* st; };
__device__ __forceinline__ XcdBarrier xcd_barrier_post(unsigned* bar, volatile LAS unsigned* st) {
  XcdBarrier b; b.bar = bar; b.x = xb_xcc_id(); b.st = st;
  if (threadIdx.x == 0) (void)xb_add(&bar[XB_XCNT(b.x)], 1u);
  return b;
}
__device__ __forceinline__ void xcd_barrier_complete(unsigned* bar, unsigned x, unsigned& nloc, unsigned& nx) {
  const unsigned G = gridDim.x * gridDim.y * gridDim.z;
  unsigned sum, cnt, mine, sp = 0u;
  for (;;) {
    sum = 0u; cnt = 0u; mine = 0u;
#pragma unroll
    for (unsigned j = 0; j < 16; ++j) { const unsigned c = xb_ld(&bar[XB_XCNT(j)]); sum += c; cnt += (c > 0u) ? 1u : 0u; mine = (j == x) ? c : mine; }
    if (sum == G) break;
    __builtin_amdgcn_s_sleep(1);
    if ((++sp & 255u) == 0u) { if (xb_ld(&bar[XB_TMO])) break; if (sp > XB_SPIN_CAP) { atomicAdd(&bar[XB_TMO], 1u); break; } }
  }
  nloc = mine > 0u ? mine : 1u; nx = cnt > 0u ? cnt : 1u;
}
__device__ __forceinline__ void xcd_barrier(const XcdBarrier& b) {
  asm volatile("s_waitcnt vmcnt(0)" ::: "memory");
  __syncthreads();
  if (threadIdx.x == 0) {
    unsigned* bar = b.bar;
    __builtin_amdgcn_s_waitcnt(0);
    unsigned nloc = b.st[0], nx = b.st[1];
    if (nloc == 0u) { xcd_barrier_complete(bar, b.x, nloc, nx); b.st[0] = nloc; b.st[1] = nx; }
    const unsigned old = xb_add(&bar[XB_XSUB(b.x)], 1u);
    const unsigned gen = old / nloc;
    if (old + 1u == (gen + 1u) * nloc) {
      __builtin_amdgcn_fence(__ATOMIC_RELEASE, "agent");
      asm volatile("s_waitcnt vmcnt(0)" ::: "memory");
      const unsigned og = xb_add(&bar[XB_TOP], 1u);
      const unsigned tg = og / nx;
      if (og + 1u == (tg + 1u) * nx) xb_add(&bar[XB_TOPGEN], 1u);
      else XB_SPIN(xb_ld(&bar[XB_TOPGEN]) == tg, bar);
      __builtin_amdgcn_fence(__ATOMIC_ACQUIRE, "agent");
      xb_add(&bar[XB_XGEN(b.x)], 1u);
      asm volatile("s_waitcnt vmcnt(0)" ::: "memory");
    } else {
      XB_SPIN(xb_ld(&bar[XB_XGEN(b.x)]) == gen, bar);
      __builtin_amdgcn_fence(__ATOMIC_ACQUIRE, "agent");
      asm volatile("s_waitcnt vmcnt(0)" ::: "memory");
    }
  }
  __syncthreads();
}

#ifndef PROBE_PRE
#define PROBE_PRE 0
#endif
#define PROBE_X 0
__global__ void __launch_bounds__(256, 2) hybrid_mega(Params p, int ph_lo, int ph_hi) {
  __shared__ __attribute__((aligned(16))) char smem[SMEM_BYTES];
  __shared__ uint4 xb_words;
  cg::grid_group grid = cg::this_grid();
  if (threadIdx.x == 0) xb_words = make_uint4(0u, 0u, 0u, 0u);
  __syncthreads();
  XcdBarrier xb = xcd_barrier_post((unsigned*)(p.ws + OFF_XBAR), (volatile LAS unsigned*)&xb_words);
  if (PROBE_PRE > 0 && ph_hi - ph_lo > 1) {
    for (int ph = 0; ph < PROBE_PRE; ++ph) { run_phase(p, ph, smem); grid.sync(); }
    if (PROBE_X) { run_phase(p, 5, smem, PROBE_X); grid.sync(); }
  }
  for (int ph = ph_lo; ph < ph_hi; ++ph) {
    run_phase(p, ph, smem);
    if (ph + 1 < ph_hi) { if (ph_hi > 1000) grid.sync(); else xcd_barrier(xb); }
  }
}

extern "C" void kernel_launch(void* const* d_in, const int* in_sizes, int n_in, void* d_out, int out_size, void* d_ws,
                              size_t ws_size, hipStream_t stream) {
  static int grid_blocks = 0;
  if (!grid_blocks) {
    int dev = 0, cus = 0, per_cu = 0;
    hipGetDevice(&dev);
    hipDeviceGetAttribute(&cus, hipDeviceAttributeMultiprocessorCount, dev);
    hipOccupancyMaxActiveBlocksPerMultiprocessor(&per_cu, hybrid_mega, 256, 0);
    if (per_cu < 1) per_cu = 1;
    if (per_cu > 2) per_cu = 2;
    grid_blocks = cus * per_cu;
  }
  if (ws_size < WS_NEEDED) fprintf(stderr, "workspace too small: %zu < %zu\n", ws_size, (size_t)WS_NEEDED);
  Params p{};
  for (int i = 0; i < 35; ++i) p.in[i] = (const float*)d_in[i];
  p.out = (float*)d_out;
  p.ws = (char*)d_ws;
  hipMemsetAsync((char*)d_ws + OFF_XBAR, 0, XCD_BAR_WORDS * sizeof(unsigned), stream);
#if MEGA
  int lo = 0, hi = N_PHASES;
  void* args[] = {&p, &lo, &hi};
  hipError_t e = hipLaunchCooperativeKernel((void*)hybrid_mega, dim3(grid_blocks), dim3(256), args, 0, stream);
  if (e != hipSuccess) fprintf(stderr, "cooperative launch failed: %s (grid %d)\n", hipGetErrorString(e), grid_blocks);
#else
  for (int ph = 0; ph < N_PHASES; ++ph) hybrid_mega<<<grid_blocks, 256, 0, stream>>>(p, ph, ph + 1);
#endif
}
```
